# Optimizing an MI355X kernel written in HIP

```python
import math
import jax, jax.numpy as jnp
from jax import lax
import numpy as np

D_MODEL = 4096
BATCH = 2
SEQ = 4096
DEPTH = 2

CTX_LEN = 256
GRID_W = 64
HEAD_DIM = 128
AXIS_DIM = HEAD_DIM // 2
ROPE_THETA = 10000.0
EPS = 1e-6
Q_BLOCK = 128
ATTN_SCALE = 1.0 / math.sqrt(HEAD_DIM)

A_WIDTH = D_MODEL // 2
A_HEADS = A_WIDTH // HEAD_DIM
A_KV_HEADS = A_HEADS // 4
A_GROUP = A_HEADS // A_KV_HEADS
B_WIDTH = D_MODEL // 4
CONV_K = 3
C_WIDTH = D_MODEL // 4
C_VDIM = 2 * HEAD_DIM
C_HEADS = C_WIDTH // C_VDIM
MIX_WIDTH = A_WIDTH + B_WIDTH + C_WIDTH

KA_COLS = A_KV_HEADS * HEAD_DIM
VA_COLS = A_KV_HEADS * HEAD_DIM
KC_COLS = C_HEADS * 2 * HEAD_DIM
VC_COLS = C_WIDTH
KV_COLS = KA_COLS + VA_COLS + KC_COLS + VC_COLS
QA_COLS = A_WIDTH
QC_COLS = C_HEADS * 2 * HEAD_DIM
REST_COLS = QA_COLS + QC_COLS + 3 * B_WIDTH + A_WIDTH + B_WIDTH + C_WIDTH
IN_COLS = KV_COLS + REST_COLS

kernel_name = "hybrid_gqa_shortconv_diffattn_prefix_dit"


def _split(u, sizes):
    idx, acc = [], 0
    for s in sizes[:-1]:
        acc += s
        idx.append(acc)
    return jnp.split(u, idx, axis=-1)


def _rms(x, g):
    xf = x.astype(jnp.float32)
    y = xf * lax.rsqrt(jnp.mean(xf * xf, axis=-1, keepdims=True) + EPS)
    return y.astype(x.dtype) * g


def _modulation(cvec, w_mod, b_mod):
    m = jax.nn.silu(cvec) @ w_mod + b_mod
    return jnp.split(m, 3, axis=-1)


def _axial_rope_tables(n):
    rows = n // GRID_W
    row = jnp.broadcast_to(jnp.arange(rows)[:, None], (rows, GRID_W)).reshape(-1)
    col = jnp.broadcast_to(jnp.arange(GRID_W)[None, :], (rows, GRID_W)).reshape(-1)
    inv = ROPE_THETA ** (-jnp.arange(0, AXIS_DIM, 2, dtype=jnp.float32) / AXIS_DIM)
    ar = row.astype(jnp.float32)[:, None] * inv
    ac = col.astype(jnp.float32)[:, None] * inv
    return (jnp.cos(ar), jnp.sin(ar), jnp.cos(ac), jnp.sin(ac))


def _rot(xp, cos, sin):
    x1, x2 = jnp.split(xp, 2, axis=-1)
    return jnp.concatenate([x1 * cos - x2 * sin, x2 * cos + x1 * sin], axis=-1)


def _apply_rope(x, tabs):
    shp = (x.shape[1],) + (1,) * (x.ndim - 3) + (AXIS_DIM // 2,)
    cr, sr, cc, sc = [t.reshape(shp).astype(x.dtype) for t in tabs]
    xr, xc = x[..., :AXIS_DIM], x[..., AXIS_DIM:]
    return jnp.concatenate([_rot(xr, cr, sr), _rot(xc, cc, sc)], axis=-1)


def _conv3(x, w):
    xp = jnp.pad(x, ((0, 0), (1, 1), (0, 0)))
    return xp[:, :-2] * w[0] + xp[:, 1:-1] * w[1] + xp[:, 2:] * w[2]


def _attend_gqa(q, k, v):
    s = jnp.einsum('bqkgd,bskd->bkgqs', q, k, preferred_element_type=jnp.float32) * ATTN_SCALE
    p = jax.nn.softmax(s, axis=-1).astype(v.dtype)
    return jnp.einsum('bkgqs,bskd->bqkgd', p, v)


def _attend_diff(q, k, v, lam):
    s = jnp.einsum('bqhcd,bshcd->bhcqs', q, k, preferred_element_type=jnp.float32) * ATTN_SCALE
    p = jax.nn.softmax(s, axis=-1)
    pd = (p[:, :, 0] - lam.astype(jnp.float32) * p[:, :, 1]).astype(v.dtype)
    return jnp.einsum('bhqs,bshe->bqhe', pd, v)


def _sweep_blocks(fn, q):
    b, s = q.shape[:2]
    nb = s // Q_BLOCK
    qb = jnp.moveaxis(q.reshape((b, nb, Q_BLOCK) + q.shape[2:]), 1, 0)
    ob = lax.map(fn, qb)
    return jnp.moveaxis(ob, 0, 1).reshape((b, s) + ob.shape[3:])


def _prep_kv(ukv, k_norm_a, tabs):
    b, t = ukv.shape[:2]
    ka, va, kc, vc = _split(ukv, [KA_COLS, VA_COLS, KC_COLS, VC_COLS])
    ka = _rms(ka.reshape(b, t, A_KV_HEADS, HEAD_DIM), k_norm_a)
    va = va.reshape(b, t, A_KV_HEADS, HEAD_DIM)
    kc = kc.reshape(b, t, C_HEADS, 2, HEAD_DIM)
    vc = vc.reshape(b, t, C_HEADS, C_VDIM)
    if tabs is not None:
        ka = _apply_rope(ka, tabs)
        kc = _apply_rope(kc, tabs)
    return ka, va, kc, vc


def _mix(urest, ka, va, kc, vc, q_norm_a, conv_w, lam, subln_g, lambda_init, w_out, tabs):
    b, t = urest.shape[:2]
    qa, qc, xb, bb, cb, za, zb, zc = _split(
        urest, [QA_COLS, QC_COLS, B_WIDTH, B_WIDTH, B_WIDTH, A_WIDTH, B_WIDTH, C_WIDTH])
    qa = _rms(qa.reshape(b, t, A_KV_HEADS, A_GROUP, HEAD_DIM), q_norm_a)
    qc = qc.reshape(b, t, C_HEADS, 2, HEAD_DIM)
    fa = lambda qblk: _attend_gqa(qblk, ka, va)
    fc = lambda qblk: _attend_diff(qblk, kc, vc, lam)
    if tabs is not None:
        qa = _apply_rope(qa, tabs)
        qc = _apply_rope(qc, tabs)
        oa = _sweep_blocks(fa, qa)
        oc = _sweep_blocks(fc, qc)
    else:
        oa = fa(qa)
        oc = fc(qc)
    oa = oa.reshape(b, t, A_WIDTH) * jax.nn.silu(za)
    yb = bb * _conv3(cb * xb, conv_w) * jax.nn.silu(zb)
    oc = (_rms(oc, subln_g) * (1.0 - lambda_init)).reshape(b, t, C_WIDTH) * jax.nn.silu(zc)
    return jnp.concatenate([oa, yb, oc], axis=-1) @ w_out


def setup_inputs(seed: int = 0) -> dict:
    key = jax.random.key(seed)
    ks = jax.random.split(key, 20)
    f32 = jnp.float32
    nrm = lambda k, shp: jax.random.normal(k, shp, f32)
    return {
        "x": nrm(ks[0], (BATCH, SEQ, D_MODEL)),
        "c": nrm(ks[1], (BATCH, D_MODEL)),
        "ctx": nrm(ks[2], (BATCH, CTX_LEN, D_MODEL)),
        "c_ctx": nrm(ks[3], (D_MODEL,)),
        "w_mod": nrm(ks[4], (DEPTH, D_MODEL, 3 * D_MODEL)) * (0.5 * D_MODEL ** -0.5),
        "b_mod": nrm(ks[5], (DEPTH, 3 * D_MODEL)) * 0.01,
        "norm_g": 1.0 + 0.02 * nrm(ks[6], (DEPTH, D_MODEL)),
        "w_in": nrm(ks[7], (DEPTH, D_MODEL, IN_COLS)) * D_MODEL ** -0.5,
        "q_norm_a": 1.0 + 0.02 * nrm(ks[8], (DEPTH, HEAD_DIM)),
        "k_norm_a": 1.0 + 0.02 * nrm(ks[9], (DEPTH, HEAD_DIM)),
        "conv_w": nrm(ks[10], (DEPTH, CONV_K, B_WIDTH)) * CONV_K ** -0.5,
        "lambda_q1": 0.1 * nrm(ks[11], (DEPTH, HEAD_DIM)),
        "lambda_k1": 0.1 * nrm(ks[12], (DEPTH, HEAD_DIM)),
        "lambda_q2": 0.1 * nrm(ks[13], (DEPTH, HEAD_DIM)),
        "lambda_k2": 0.1 * nrm(ks[14], (DEPTH, HEAD_DIM)),
        "subln_g": 1.0 + 0.02 * nrm(ks[15], (DEPTH, C_VDIM)),
        "w_out": nrm(ks[16], (DEPTH, MIX_WIDTH, D_MODEL)) * MIX_WIDTH ** -0.5,
        "final_g": 1.0 + 0.02 * nrm(ks[17], (D_MODEL,)),
    }


def reference(x, c, ctx, c_ctx, w_mod, b_mod, norm_g, w_in, q_norm_a, k_norm_a, conv_w,
              lambda_q1, lambda_k1, lambda_q2, lambda_k2, subln_g, w_out, final_g):
    tabs = _axial_rope_tables(x.shape[1])
    h, hc = x, ctx
    for i in range(DEPTH):
        update_ctx = i < DEPTH - 1
        lambda_init = 0.8 - 0.6 * math.exp(-0.3 * i)
        lam = (jnp.exp(jnp.sum(lambda_q1[i] * lambda_k1[i])) -
               jnp.exp(jnp.sum(lambda_q2[i] * lambda_k2[i])) + lambda_init)
        shift, scale, gate = [m[:, None, :] for m in _modulation(c, w_mod[i], b_mod[i])]
        cshift, cscale, cgate = _modulation(c_ctx, w_mod[i], b_mod[i])
        n = _rms(h, norm_g[i]) * (1.0 + scale) + shift
        nc = _rms(hc, norm_g[i]) * (1.0 + cscale) + cshift
        u = n @ w_in[i]
        uc = nc @ (w_in[i] if update_ctx else w_in[i][:, :KV_COLS])
        kvl = _prep_kv(u[..., :KV_COLS], k_norm_a[i], tabs)
        kvc = _prep_kv(uc[..., :KV_COLS], k_norm_a[i], None)
        ka, va, kc, vc = [jnp.concatenate([a, b_], axis=1) for a, b_ in zip(kvc, kvl)]
        out = _mix(u[..., KV_COLS:], ka, va, kc, vc, q_norm_a[i], conv_w[i], lam, subln_g[i],
                   lambda_init, w_out[i], tabs)
        if update_ctx:
            out_c = _mix(uc[..., KV_COLS:], *kvc, q_norm_a[i], conv_w[i], lam, subln_g[i],
                         lambda_init, w_out[i], None)
            hc = hc + cgate * out_c
        h = h + gate * out
    return _rms(h, final_g)
```

```cpp
#include <hip/hip_runtime.h>
#include <hip/hip_bf16.h>
#include <cstdio>
#include <cstdint>

#ifndef MK_REP
#define MK_REP 0
#endif
#ifndef MK_AVAR
#define MK_AVAR 0
#endif
#ifndef MK_PER_PHASE
#define MK_PER_PHASE 0
#endif

__device__ __forceinline__ int hw_lane() { int l; asm volatile("v_mbcnt_lo_u32_b32 %0, -1, 0\n\tv_mbcnt_hi_u32_b32 %0, -1, %0" : "=&v"(l)); return l; }
namespace pg8 {
#define PG8_LAS __attribute__((address_space(3)))
typedef unsigned short bf16_t;
typedef short bf16x8 __attribute__((ext_vector_type(8)));
typedef float f32x4 __attribute__((ext_vector_type(4)));
typedef unsigned u32x4 __attribute__((ext_vector_type(4)));
constexpr int BM = 256, BK = 64, HALF = 128, HTB = HALF * BK * 2, STAGE_BYTES = 8 * HTB, NXCD = 8, WGM = 8;

__host__ __device__ __forceinline__ int lds_byte(int r, int c) { const int st = (r >> 4) * 2 + (c >> 5), rr = r & 15, cc = c & 31, ob = rr * 64 + cc * 2; return st * 1024 + (ob ^ (((ob >> 9) & 1) << 5)); }
__host__ __device__ __forceinline__ void stage_rc(int b, int& R, int& C) { const int st = b / 1024, sb = b % 1024, swz = sb ^ (((sb >> 9) & 1) << 5); R = (st >> 1) * 16 + swz / 64; C = (st & 1) * 32 + (swz % 64) / 2; }
__host__ __device__ __forceinline__ int perm32(int rho) { const int n = rho >> 4, i = rho & 15; return 8 * (i >> 2) + 4 * n + (i & 3); }

struct Unit { int pm, pn, ko, f8; };
struct Gemm { const bf16_t* A; const bf16_t* Bt; int lda, ldb, K; const unsigned char* A8 = nullptr; const unsigned char* B8 = nullptr; };
constexpr unsigned long long F8MASK = 0xFFF0FFULL | (0xFFULL << 36);
constexpr int F8N = 28, BFN = 52 - 28;
static_assert(__builtin_popcountll(F8MASK) == F8N, "tile set");
__host__ __device__ __forceinline__ bool f8_tile(int pn) { return (F8MASK >> pn) & 1ULL; }
__host__ __device__ __forceinline__ int f8_tile_index(int pn) { return __builtin_popcountll(F8MASK & ((1ULL << pn) - 1ULL)); }
__host__ __device__ __forceinline__ int nth_tile(int v, bool set) { unsigned long long m = set ? F8MASK : ~F8MASK; for (int i = 0; i < v; ++i) m &= m - 1ULL; return __builtin_ctzll(m); }

struct StaticOrder {
    int nM, nN, nwg, G, c;
    __host__ __device__ void init(int M, int N, int G_, int c_) { nM = M / BM; nN = N / BM; nwg = nM * nN; G = G_; c = c_; }
    __host__ __device__ bool next(int i, Unit& u) const {
        const long L = (long)i * G + c; if (L >= nwg) return false;
        int wgid = (int)L; { const int q = nwg / NXCD, r = nwg % NXCD, xcd = wgid % NXCD, off = wgid / NXCD; wgid = (xcd < r ? xcd * (q + 1) : r * (q + 1) + (xcd - r) * q) + off; }
        const int nig = WGM * nN, gid = wgid / nig, fm = gid * WGM, gsz = (nM - fm) < WGM ? (nM - fm) : WGM;
        u.pm = fm + ((wgid % nig) % gsz); u.pn = (wgid % nig) / gsz; u.ko = 0; u.f8 = 0; return true;
    }
    __device__ __forceinline__ void a_ready(const Unit&) const {}
    __device__ __forceinline__ void done(const Unit&) const {}
};
struct RowMapOrder {
    StaticOrder so; int latent_only; int ctx_ntiles; int colmap = 0;
    __device__ __forceinline__ bool next(int i, Unit& u) const {
        if (so.next(i, u)) { if (latent_only) u.pm = (u.pm >> 4) * 17 + 1 + (u.pm & 15); if (colmap) u.pn = nth_tile(u.pn, colmap == 1); return true; }
        const int L = i * so.G + so.c - so.nwg;
        if (L < 2 * ctx_ntiles) { u.pm = (L / ctx_ntiles) * 17; u.pn = colmap ? nth_tile(L % ctx_ntiles, colmap == 1) : L % ctx_ntiles; u.ko = 0; u.f8 = 0; return true; }
        return false; }
    __device__ __forceinline__ void a_ready(const Unit&) const {}
    __device__ __forceinline__ void done(const Unit&) const {}
};

struct CtxSplitOrder {
    int G, c;
    __device__ __forceinline__ bool next(int i, Unit& u) const { const int L = i * G + c; if (L >= 256) return false; const int tile = L >> 3; u.pm = (tile >> 4) * 17; u.pn = tile & 15; u.ko = (L & 7) * 512; u.f8 = 0; return true; }
    __device__ __forceinline__ void a_ready(const Unit&) const {}
    __device__ __forceinline__ void done(const Unit&) const {}
};

__device__ __forceinline__ unsigned cvt_pk_bf16(float lo, float hi) { unsigned r; asm volatile("v_cvt_pk_bf16_f32 %0, %1, %2" : "=v"(r) : "v"(lo), "v"(hi)); return r; }

struct EpiBf16 {
    static constexpr bool PERM = true, AFTER_DRAIN = false;
    bf16_t* O; int ldc;
    __device__ __forceinline__ void operator()(const f32x4 (&acc)[2][2][4][2], const Unit& u, int wr, int wc, int fr, int fq) const {
        asm volatile("" : "+v"(fr), "+v"(fq));
        const int row0 = u.pm * BM + wr * 64 + fr; const int col0 = u.pn * BM + wc * 32 + 8 * fq;
#pragma unroll
        for (int ai = 0; ai < 2; ++ai)
#pragma unroll
            for (int m = 0; m < 4; ++m) { bf16_t* rowp = O + (size_t)(row0 + ai * HALF + m * 16) * ldc + col0;
#pragma unroll
                for (int bj = 0; bj < 2; ++bj) { const f32x4 v0 = acc[ai][bj][m][0], v1 = acc[ai][bj][m][1];
                    u32x4 w; w.x = cvt_pk_bf16(v0[0], v0[1]); w.y = cvt_pk_bf16(v0[2], v0[3]); w.z = cvt_pk_bf16(v1[0], v1[1]); w.w = cvt_pk_bf16(v1[2], v1[3]);
                    *(u32x4*)(rowp + bj * HALF) = w; } }
    }
};
struct EpiGate {
    static constexpr bool PERM = true, AFTER_DRAIN = false;
    bf16_t* D; const float* mod;
    __device__ __forceinline__ void operator()(const f32x4 (&acc)[2][2][4][2], const Unit& u, int wr, int wc, int fr, int fq) const {
        const float* gate = mod + (u.pm / 17) * 12288 + 8192;
        const int row0 = u.pm * BM + wr * 64 + fr, col0 = u.pn * BM + wc * 32 + 8 * fq;
        f32x4 gv[2][2];
#pragma unroll
        for (int bj = 0; bj < 2; ++bj)
#pragma unroll
            for (int n = 0; n < 2; ++n) gv[bj][n] = *(const f32x4*)(gate + col0 + bj * HALF + 4 * n);
#pragma unroll
        for (int ai = 0; ai < 2; ++ai)
#pragma unroll
            for (int m = 0; m < 4; ++m) { bf16_t* rowp = D + (size_t)(row0 + ai * HALF + m * 16) * 4096 + col0;
#pragma unroll
                for (int bj = 0; bj < 2; ++bj) { const f32x4 v0 = acc[ai][bj][m][0] * gv[bj][0], v1 = acc[ai][bj][m][1] * gv[bj][1];
                    u32x4 w; w.x = cvt_pk_bf16(v0[0], v0[1]); w.y = cvt_pk_bf16(v0[2], v0[3]); w.z = cvt_pk_bf16(v1[0], v1[1]); w.w = cvt_pk_bf16(v1[2], v1[3]);
                    *(u32x4*)(rowp + bj * HALF) = w; } }
    }
};

struct EpiSlab {
    static constexpr bool PERM = false, AFTER_DRAIN = false;
    float* slab;
    __device__ __forceinline__ void operator()(const f32x4 (&acc)[2][2][4][2], const Unit& u, int wr, int wc, int fr, int fq) const {
        float* base = slab + ((size_t)(u.ko >> 9) * 512 + (size_t)(u.pm / 17) * 256) * 4096;
        const int lr0 = wr * 64 + fr, col0 = u.pn * BM + wc * 32 + 4 * fq;
#pragma unroll
        for (int ai = 0; ai < 2; ++ai)
#pragma unroll
            for (int m = 0; m < 4; ++m) { float* rowp = base + (size_t)(lr0 + ai * HALF + m * 16) * 4096 + col0;
#pragma unroll
                for (int bj = 0; bj < 2; ++bj)
#pragma unroll
                    for (int n = 0; n < 2; ++n) *(f32x4*)(rowp + bj * HALF + n * 16) = acc[ai][bj][m][n]; }
    }
};

typedef int v8i_t __attribute__((ext_vector_type(8)));
__device__ __forceinline__ v8i_t cat8(bf16x8 lo, bf16x8 hi) { typedef int i4_t __attribute__((ext_vector_type(4))); const i4_t a = __builtin_bit_cast(i4_t, lo), b = __builtin_bit_cast(i4_t, hi); return (v8i_t){a.x, a.y, a.z, a.w, b.x, b.y, b.z, b.w}; }
template <class Epi, class Sched, bool ALIGN_EPI = false, bool SP2 = false, bool MIXF8 = false>
__device__ __forceinline__ void gemm_phase(PG8_LAS unsigned char* lds, const Gemm g, const Sched& S, const Epi& E, int wv) {
    int tid = wv * 64 + hw_lane(); asm volatile("" : "+v"(tid));
    const int wid = __builtin_amdgcn_readfirstlane(tid >> 6), lane = tid & 63, wr = wid >> 2, wc = wid & 3, fr = lane & 15, fq = lane >> 4;
    const int K = g.K, nt = K / BK;
    unsigned voffA[2], voffB[2];
    const int pitchA = MIXF8 ? g.lda : g.lda * 2, pitchB = MIXF8 ? g.ldb : g.ldb * 2;
#pragma unroll
    for (int i = 0; i < 2; ++i) { int R, C; stage_rc(tid * 16 + i * 8192, R, C); const int Rb = Epi::PERM ? ((R & ~31) + perm32(R & 31)) : R;
        voffA[i] = (unsigned)(R * pitchA + C * 2); voffB[i] = (unsigned)(Rb * pitchB + C * 2); }
    const size_t kstep = (size_t)(BK * 2);
    const size_t hstepA = (size_t)HALF * pitchA, hstepB = (size_t)HALF * pitchB;
    const size_t tstepA = 2 * hstepA, tstepB = 2 * hstepB;
    const unsigned ldsw = (unsigned)wid * 1024u, ldsb = (unsigned)(size_t)lds;
    const int aoff = lds_byte(wr * 64 + fr, fq * 8), boff = lds_byte(wc * 32 + fr, fq * 8);
#define PG8_SA(b, h) (((b) * 2 + (h)) * HTB)
#define PG8_SB(b, h) ((4 + (b) * 2 + (h)) * HTB)
#define PG8_STAGE(bufoff, gbase, voff) do { _Pragma("unroll") for (int _i = 0; _i < 2; ++_i) \
        asm volatile("s_mov_b32 m0, %2\n\ts_nop 0\n\tglobal_load_lds_dwordx4 %0, %1" :: "v"((voff)[_i]), "s"((const char*)(gbase)), "s"((unsigned)__builtin_amdgcn_readfirstlane((int)(ldsb + (unsigned)(bufoff) + ldsw + _i * 8192u))) : "memory", "m0"); } while (0)
#define PG8_LDA(dst, b, h) do { if constexpr (MIXF8) { _Pragma("unroll") for (int m = 0; m < 4; ++m) dst##8[m] = cat8(*(const PG8_LAS bf16x8*)(lds + PG8_SA(b, h) + aoff + m * 2048), *(const PG8_LAS bf16x8*)(lds + PG8_SA(b, h) + aoff + m * 2048 + 1024)); } \
    else { _Pragma("unroll") for (int m = 0; m < 4; ++m) _Pragma("unroll") for (int k = 0; k < 2; ++k) dst[m][k] = *(const PG8_LAS bf16x8*)(lds + PG8_SA(b, h) + aoff + m * 2048 + k * 1024); } } while (0)
#define PG8_LDB(dst, b, h) do { if constexpr (MIXF8) { _Pragma("unroll") for (int n = 0; n < 2; ++n) dst##8[n] = cat8(*(const PG8_LAS bf16x8*)(lds + PG8_SB(b, h) + boff + n * 2048), *(const PG8_LAS bf16x8*)(lds + PG8_SB(b, h) + boff + n * 2048 + 1024)); } \
    else { _Pragma("unroll") for (int n = 0; n < 2; ++n) _Pragma("unroll") for (int k = 0; k < 2; ++k) dst[n][k] = *(const PG8_LAS bf16x8*)(lds + PG8_SB(b, h) + boff + n * 2048 + k * 1024); } } while (0)
#define PG8_MMA(ai, bj, At, Bt) do { __builtin_amdgcn_s_setprio(1); if constexpr (MIXF8) { _Pragma("unroll") for (int m = 0; m < 4; ++m) _Pragma("unroll") for (int n = 0; n < 2; ++n) \
        acc[ai][bj][m][n] = __builtin_amdgcn_mfma_scale_f32_16x16x128_f8f6f4(Bt##8[n], At##8[m], acc[ai][bj][m][n], 0, 0, 0, 0x75757575, 0, 0x7b7b7b7b); } \
      else { _Pragma("unroll") for (int m = 0; m < 4; ++m) _Pragma("unroll") for (int n = 0; n < 2; ++n) _Pragma("unroll") for (int k = 0; k < 2; ++k) \
        acc[ai][bj][m][n] = __builtin_amdgcn_mfma_f32_16x16x32_bf16(Bt[n][k], At[m][k], acc[ai][bj][m][n], 0, 0, 0); } __builtin_amdgcn_s_setprio(0); } while (0)
#define PG8_WAIT_V(n) asm volatile("s_waitcnt vmcnt(" #n ")" ::: "memory")
#define PG8_WAIT_L(n) asm volatile("s_waitcnt lgkmcnt(" #n ")" ::: "memory")
#define PG8_BAR __builtin_amdgcn_s_barrier()
#define PG8_SCHED __builtin_amdgcn_sched_barrier(0)
    Unit cur, nxt; int ui = 0;
    if (!S.next(0, cur)) return;
    f32x4 acc[2][2][4][2];
#pragma unroll
    for (int a = 0; a < 2; ++a)
#pragma unroll
        for (int b = 0; b < 2; ++b)
#pragma unroll
            for (int m = 0; m < 4; ++m)
#pragma unroll
                for (int n = 0; n < 2; ++n) acc[a][b][m][n] = (f32x4){0.f, 0.f, 0.f, 0.f};
    bf16x8 At[4][2], B0[2][2], B1[2][2]; v8i_t At8[4], B08[2], B18[2];
#define PG8_ABASE(u) (MIXF8 ? (const char*)g.A8 + (size_t)(u).pm * tstepA : (const char*)g.A + (size_t)(u).pm * tstepA + (size_t)(u).ko * 2)
#define PG8_BBASE(u) (MIXF8 ? (const char*)g.B8 + (size_t)f8_tile_index((u).pn) * tstepB : (const char*)g.Bt + (size_t)(u).pn * tstepB + (size_t)(u).ko * 2)
    const char* cA = PG8_ABASE(cur); const char* cB = PG8_BBASE(cur);
    const int cnt = MIXF8 ? nt / 2 : nt;
    S.a_ready(cur);
    if constexpr (SP2) {
        PG8_STAGE(PG8_SB(0, 0), cB, voffB); PG8_STAGE(PG8_SB(0, 1), cB + hstepB, voffB); PG8_STAGE(PG8_SA(0, 0), cA, voffA); PG8_STAGE(PG8_SA(0, 1), cA + hstepA, voffA);
        if (wr == 1) PG8_BAR;
        PG8_WAIT_V(2); PG8_BAR;
        PG8_STAGE(PG8_SB(1, 0), cB + kstep, voffB); PG8_STAGE(PG8_SA(1, 0), cA + kstep, voffA); PG8_STAGE(PG8_SB(1, 1), cB + hstepB + kstep, voffB);
        PG8_WAIT_V(6); PG8_BAR;
    } else {
        PG8_STAGE(PG8_SB(0, 0), cB, voffB); PG8_STAGE(PG8_SA(0, 0), cA, voffA); PG8_STAGE(PG8_SB(0, 1), cB + hstepB, voffB); PG8_STAGE(PG8_SA(0, 1), cA + hstepA, voffA);
        if (wr == 1) PG8_BAR;
        PG8_WAIT_V(4); PG8_BAR;
        PG8_STAGE(PG8_SB(1, 0), cB + kstep, voffB); PG8_STAGE(PG8_SA(1, 0), cA + kstep, voffA); PG8_STAGE(PG8_SB(1, 1), cB + hstepB + kstep, voffB);
        PG8_WAIT_V(6); PG8_BAR;
    }
    for (;;) {
        const bool has_next = S.next(ui + 1, nxt);
        const char* nA = has_next ? PG8_ABASE(nxt) : cA; const char* nB = has_next ? PG8_BBASE(nxt) : cB;
        for (int t = 0; t < cnt; t += 2) {
            const bool last = (t == cnt - 2);
            const char* a1 = cA + (size_t)(t + 1) * kstep;
            const char* a2 = last ? nA : cA + (size_t)(t + 2) * kstep; const char* b2 = last ? nB : cB + (size_t)(t + 2) * kstep;
            const char* a3 = a2 + kstep; const char* b3 = b2 + kstep;
            if (last && has_next) S.a_ready(nxt);
            if constexpr (SP2) {
            PG8_LDB(B0, 0, 0); PG8_LDB(B1, 0, 1); PG8_SCHED; PG8_LDA(At, 0, 0); PG8_STAGE(PG8_SA(1, 1), a1 + hstepA, voffA);
            PG8_WAIT_V(8); PG8_WAIT_L(0); PG8_BAR; PG8_MMA(0, 0, At, B0); PG8_MMA(0, 1, At, B1); PG8_BAR; PG8_SCHED;
            PG8_LDA(At, 0, 1); PG8_STAGE(PG8_SB(0, 0), b2, voffB); PG8_STAGE(PG8_SB(0, 1), b2 + hstepB, voffB); PG8_STAGE(PG8_SA(0, 0), a2, voffA);
            PG8_WAIT_V(8); PG8_WAIT_L(0); PG8_BAR; PG8_MMA(1, 0, At, B0); PG8_MMA(1, 1, At, B1); PG8_BAR; PG8_SCHED;
            PG8_LDB(B0, 1, 0); PG8_LDB(B1, 1, 1); PG8_SCHED; PG8_LDA(At, 1, 0); PG8_STAGE(PG8_SA(0, 1), a2 + hstepA, voffA);
            PG8_WAIT_V(8); PG8_WAIT_L(0); PG8_BAR; PG8_MMA(0, 0, At, B0); PG8_MMA(0, 1, At, B1); PG8_BAR; PG8_SCHED;
            PG8_LDA(At, 1, 1); PG8_STAGE(PG8_SB(1, 0), b3, voffB); PG8_STAGE(PG8_SB(1, 1), b3 + hstepB, voffB); PG8_STAGE(PG8_SA(1, 0), a3, voffA);
            PG8_WAIT_V(8); PG8_WAIT_L(0); PG8_BAR; PG8_MMA(1, 0, At, B0); PG8_MMA(1, 1, At, B1); PG8_BAR; PG8_SCHED;
            } else {
            PG8_LDB(B0, 0, 0); PG8_SCHED; PG8_LDA(At, 0, 0); PG8_STAGE(PG8_SA(1, 1), a1 + hstepA, voffA);
            PG8_WAIT_L(8); PG8_BAR; PG8_WAIT_L(0); PG8_MMA(0, 0, At, B0); PG8_BAR; PG8_SCHED;
            PG8_LDB(B1, 0, 1); PG8_STAGE(PG8_SB(0, 0), b2, voffB);
            PG8_BAR; PG8_WAIT_L(0); PG8_MMA(0, 1, At, B1); PG8_BAR;
            PG8_LDA(At, 0, 1); PG8_STAGE(PG8_SA(0, 0), a2, voffA);
            PG8_BAR; PG8_WAIT_L(0); PG8_MMA(1, 0, At, B0); PG8_BAR; PG8_SCHED;
            PG8_STAGE(PG8_SB(0, 1), b2 + hstepB, voffB);
            PG8_WAIT_V(6); PG8_BAR; PG8_MMA(1, 1, At, B1); PG8_BAR;
            PG8_LDB(B0, 1, 0); PG8_SCHED; PG8_LDA(At, 1, 0); PG8_STAGE(PG8_SA(0, 1), a2 + hstepA, voffA);
            PG8_WAIT_L(8); PG8_BAR; PG8_WAIT_L(0); PG8_MMA(0, 0, At, B0); PG8_BAR; PG8_SCHED;
            PG8_LDB(B1, 1, 1); PG8_STAGE(PG8_SB(1, 0), b3, voffB);
            PG8_BAR; PG8_WAIT_L(0); PG8_MMA(0, 1, At, B1); PG8_BAR;
            PG8_LDA(At, 1, 1); PG8_STAGE(PG8_SA(1, 0), a3, voffA);
            PG8_BAR; PG8_WAIT_L(0); PG8_MMA(1, 0, At, B0); PG8_BAR; PG8_SCHED;
            PG8_STAGE(PG8_SB(1, 1), b3 + hstepB, voffB);
            PG8_WAIT_V(6); PG8_BAR; PG8_MMA(1, 1, At, B1); PG8_BAR;
            }
        }
        if constexpr (ALIGN_EPI) { if (wr == 0) PG8_BAR; }
        if constexpr (!Epi::AFTER_DRAIN) { const int le = hw_lane() & 63; E(acc, cur, wr, wc, le & 15, le >> 4); S.done(cur); }
        if (!has_next) break;
#pragma unroll
        for (int a = 0; a < 2; ++a)
#pragma unroll
            for (int b = 0; b < 2; ++b)
#pragma unroll
                for (int m = 0; m < 4; ++m)
#pragma unroll
                    for (int n = 0; n < 2; ++n) acc[a][b][m][n] = (f32x4){0.f, 0.f, 0.f, 0.f};
        cur = nxt; cA = nA; cB = nB; ++ui;
        if constexpr (ALIGN_EPI) { if (wr == 1) PG8_BAR; }
    }
    PG8_WAIT_V(0);
    if constexpr (!ALIGN_EPI) { if (wr == 0) PG8_BAR; }
    PG8_BAR;
#undef PG8_ABASE
#undef PG8_BBASE
#undef PG8_SA
#undef PG8_SB
#undef PG8_STAGE
#undef PG8_LDA
#undef PG8_LDB
#undef PG8_MMA
#undef PG8_WAIT_V
#undef PG8_WAIT_L
#undef PG8_BAR
#undef PG8_SCHED
}
}

namespace att {
using bf16 = __hip_bfloat16;
constexpr int   D = 128, NW = 8, QBLK = 32, KVBLK = 64;
constexpr float SCALE = 0.088388347648318440f;
constexpr float THR = 8.f;
constexpr size_t SHM_V = KVBLK * D * 2, SHM_K = KVBLK * D * 2, SHM_ATTN = 2 * SHM_V + 2 * SHM_K + NW * 64 * 4;
using bf16x8 = __attribute__((ext_vector_type(8))) short;
using s16x4  = __attribute__((ext_vector_type(4))) short;
using f32x16 = __attribute__((ext_vector_type(16))) float;
using u32x4  = __attribute__((ext_vector_type(4))) unsigned;
#define KSWZ(row, colB) ((row) * 256 + ((colB) ^ (((row) & 7) << 4)))
#define SBAR() __builtin_amdgcn_sched_barrier(0)
__device__ __forceinline__ int crow(int r, int hi) { return (r & 3) + 8 * (r >> 2) + 4 * hi; }
__device__ __forceinline__ unsigned cvtpk(float lo, float hi) { unsigned r; asm volatile("v_cvt_pk_bf16_f32 %0, %1, %2" : "=v"(r) : "v"(lo), "v"(hi)); return r; }
__device__ __forceinline__ bf16x8 ld8(const bf16* p) { return *reinterpret_cast<const bf16x8*>(p); }

__device__ __forceinline__ void partialSM(f32x16& p0, f32x16& p1, float& m_reg, float& mn, float& alpha) {
  constexpr float C = SCALE * 1.4426950408889634f;
  float pmax = p0[0]; for (int r = 1; r < 16; ++r) pmax = fmaxf(pmax, p0[r]); for (int r = 0; r < 16; ++r) pmax = fmaxf(pmax, p1[r]);
  { auto rr = __builtin_amdgcn_permlane32_swap(__float_as_uint(pmax), __float_as_uint(pmax), false, false);
    pmax = fmaxf(__uint_as_float(rr[0]), __uint_as_float(rr[1])); }
  if (__builtin_expect(__all(pmax - m_reg <= THR / SCALE), 1)) { mn = m_reg; alpha = 1.f; }
  else { mn = fmaxf(m_reg, pmax); alpha = __builtin_amdgcn_exp2f((m_reg - mn) * C); m_reg = mn; }
  float mnC = -mn * C;
  for (int r = 0; r < 16; ++r) p0[r] = fmaf(p0[r], C, mnC); for (int r = 0; r < 16; ++r) p1[r] = fmaf(p1[r], C, mnC);
  for (int r = 0; r < 16; ++r) p0[r] = __builtin_amdgcn_exp2f(p0[r]);
}
__device__ __forceinline__ void finishSM(f32x16& p0, f32x16& p1, float alpha, float& l_reg, bf16x8& pa0, bf16x8& pa1, bf16x8& pa2, bf16x8& pa3) {
  for (int r = 0; r < 16; ++r) p1[r] = __builtin_amdgcn_exp2f(p1[r]);
  float ps = 0; for (int r = 0; r < 16; ++r) ps += p0[r]; for (int r = 0; r < 16; ++r) ps += p1[r];
  { auto rr = __builtin_amdgcn_permlane32_swap(__float_as_uint(ps), __float_as_uint(ps), false, false);
    ps = __uint_as_float(rr[0]) + __uint_as_float(rr[1]); }
  l_reg = l_reg * alpha + ps;
#define PK4(P, BASE, OUT) do { unsigned a0 = cvtpk(P[BASE + 0], P[BASE + 1]), a1 = cvtpk(P[BASE + 2], P[BASE + 3]);   \
    unsigned b0 = cvtpk(P[BASE + 4], P[BASE + 5]), b1 = cvtpk(P[BASE + 6], P[BASE + 7]);                              \
    auto r0 = __builtin_amdgcn_permlane32_swap(a0, b0, false, false); auto r1 = __builtin_amdgcn_permlane32_swap(a1, b1, false, false); \
    u32x4 w = {r0[0], r1[0], r0[1], r1[1]}; OUT = *reinterpret_cast<bf16x8*>(&w); } while (0)
  PK4(p0, 0, pa0); PK4(p0, 8, pa1); PK4(p1, 0, pa2); PK4(p1, 8, pa3);
#undef PK4
}
__device__ __forceinline__ void qkt(f32x16& p0, f32x16& p1, const bf16* Ks, const bf16x8* qr, int r32, int hi) {
  p0 = f32x16{}; p1 = f32x16{};
  for (int d0 = 0; d0 < 8; ++d0) { int cb = (d0 * 16 + hi * 8) * 2;
    bf16x8 b0 = *reinterpret_cast<const bf16x8*>((const char*)Ks + KSWZ(r32, cb));
    bf16x8 b1 = *reinterpret_cast<const bf16x8*>((const char*)Ks + KSWZ(32 + r32, cb));
    p0 = __builtin_amdgcn_mfma_f32_32x32x16_bf16(b0, qr[d0], p0, 0, 0, 0);
    p1 = __builtin_amdgcn_mfma_f32_32x32x16_bf16(b1, qr[d0], p1, 0, 0, 0); }
}
__device__ __forceinline__ int v_st(int k, int c) { const int kk = (k & ~0xC) | ((k & 4) << 1) | ((k & 8) >> 1); return ((kk >> 3) * 4 + (c >> 5)) * 512 + ((kk & 7) * 32 + (c & 31)) * 2; }
__device__ __forceinline__ int v_rd_base(int lane) { return ((lane & 3) << 3) | (((lane >> 2) & 3) << 6) | (((lane >> 4) & 1) << 5) | (((lane >> 5) & 1) << 8); }
constexpr int v_rd_off(int d0, int ks, int half) { return d0 * 512 + ks * 4096 + half * 2048; }
template <int OFF> __device__ __forceinline__ s16x4 tr_read(int vb) {
  s16x4 r; asm volatile("ds_read_b64_tr_b16 %0, %1 offset:%2" : "=&v"(r) : "v"(vb), "i"(OFF) : "memory"); return r;
}
template <int D0> __device__ __forceinline__ void pv_one(f32x16& od, int vb, bf16x8 pa0, bf16x8 pa1, bf16x8 pa2, bf16x8 pa3) {
  const s16x4 l0 = tr_read<v_rd_off(D0, 0, 0)>(vb), h0 = tr_read<v_rd_off(D0, 0, 1)>(vb), l1 = tr_read<v_rd_off(D0, 1, 0)>(vb), h1 = tr_read<v_rd_off(D0, 1, 1)>(vb);
  const s16x4 l2 = tr_read<v_rd_off(D0, 2, 0)>(vb), h2 = tr_read<v_rd_off(D0, 2, 1)>(vb), l3 = tr_read<v_rd_off(D0, 3, 0)>(vb), h3 = tr_read<v_rd_off(D0, 3, 1)>(vb);
  asm volatile("s_waitcnt lgkmcnt(0)" ::: "memory"); SBAR();
#define PK(L, H) (bf16x8){L[0], L[1], L[2], L[3], H[0], H[1], H[2], H[3]}
  od = __builtin_amdgcn_mfma_f32_32x32x16_bf16(pa0, PK(l0, h0), od, 0, 0, 0);
  od = __builtin_amdgcn_mfma_f32_32x32x16_bf16(pa1, PK(l1, h1), od, 0, 0, 0);
  od = __builtin_amdgcn_mfma_f32_32x32x16_bf16(pa2, PK(l2, h2), od, 0, 0, 0);
  od = __builtin_amdgcn_mfma_f32_32x32x16_bf16(pa3, PK(l3, h3), od, 0, 0, 0);
#undef PK
}
__device__ __forceinline__ void pv_d0(f32x16* o, int vb, bf16x8 pa0, bf16x8 pa1, bf16x8 pa2, bf16x8 pa3) {
  pv_one<0>(o[0], vb, pa0, pa1, pa2, pa3); pv_one<1>(o[1], vb, pa0, pa1, pa2, pa3); pv_one<2>(o[2], vb, pa0, pa1, pa2, pa3); pv_one<3>(o[3], vb, pa0, pa1, pa2, pa3);
}

__device__ __forceinline__ float shx(float v, int mask, int lane) { return __int_as_float(__builtin_amdgcn_ds_bpermute((lane ^ mask) << 2, __float_as_int(v))); }
typedef int v8i32 __attribute__((ext_vector_type(8)));
constexpr float QS8 = 0.088388347648318440f * 1.4426950408889634f * 128.f;
template <bool F8OUT = false>
__device__ __forceinline__ void q_prep(bf16x8 (&qr)[8], const float* __restrict__ gn, const float* __restrict__ rope, int t, int hi, int lane, v8i32* q8 = nullptr) {
  float x[8][8];
#pragma unroll
  for (int d0 = 0; d0 < 8; ++d0) { const u32x4 w = *reinterpret_cast<const u32x4*>(&qr[d0]);
    x[d0][0] = __uint_as_float(w.x << 16); x[d0][1] = __uint_as_float(w.x & 0xffff0000u); x[d0][2] = __uint_as_float(w.y << 16); x[d0][3] = __uint_as_float(w.y & 0xffff0000u);
    x[d0][4] = __uint_as_float(w.z << 16); x[d0][5] = __uint_as_float(w.z & 0xffff0000u); x[d0][6] = __uint_as_float(w.w << 16); x[d0][7] = __uint_as_float(w.w & 0xffff0000u); }
  if (gn) {
    float ss = 0.f;
#pragma unroll
    for (int d0 = 0; d0 < 8; ++d0)
#pragma unroll
      for (int i = 0; i < 8; ++i) ss += x[d0][i] * x[d0][i];
    ss += shx(ss, 32, lane);
    const float rstd = 1.f / sqrtf(ss * (1.f / 128.f) + 1e-6f);
#pragma unroll
    for (int d0 = 0; d0 < 8; ++d0) { const float4 g0 = *(const float4*)(gn + d0 * 16 + hi * 8), g1 = *(const float4*)(gn + d0 * 16 + hi * 8 + 4);
      x[d0][0] *= rstd * g0.x; x[d0][1] *= rstd * g0.y; x[d0][2] *= rstd * g0.z; x[d0][3] *= rstd * g0.w; x[d0][4] *= rstd * g1.x; x[d0][5] *= rstd * g1.y; x[d0][6] *= rstd * g1.z; x[d0][7] *= rstd * g1.w; }
  }
  if (rope) {
#pragma unroll
    for (int hf = 0; hf < 2; ++hf) { const int pos = hf ? (t & 63) : (t >> 6);
#pragma unroll
      for (int q1 = 0; q1 < 2; ++q1) { const int jx = q1 * 16 + hi * 8;
        const float4 c0 = *(const float4*)(rope + pos * 32 + jx), c1 = *(const float4*)(rope + pos * 32 + jx + 4), s0 = *(const float4*)(rope + 2048 + pos * 32 + jx), s1 = *(const float4*)(rope + 2048 + pos * 32 + jx + 4);
        const float cs[8] = {c0.x, c0.y, c0.z, c0.w, c1.x, c1.y, c1.z, c1.w}, sn[8] = {s0.x, s0.y, s0.z, s0.w, s1.x, s1.y, s1.z, s1.w};
        const int da = hf * 4 + q1, db = da + 2;
#pragma unroll
        for (int i = 0; i < 8; ++i) { const float a = x[da][i], b = x[db][i]; x[da][i] = a * cs[i] - b * sn[i]; x[db][i] = b * cs[i] + a * sn[i]; } } }
  }
#pragma unroll
  for (int d0 = 0; d0 < 8; ++d0) { u32x4 w = {cvtpk(x[d0][0], x[d0][1]), cvtpk(x[d0][2], x[d0][3]), cvtpk(x[d0][4], x[d0][5]), cvtpk(x[d0][6], x[d0][7])}; qr[d0] = *reinterpret_cast<bf16x8*>(&w); }
  if constexpr (F8OUT) {
#pragma unroll
    for (int ds = 0; ds < 2; ++ds)
#pragma unroll
      for (int w = 0; w < 8; ++w) { const int d0 = ds * 4 + (w >> 1), i = (w & 1) * 4; unsigned r = 0u;
        r = __builtin_amdgcn_cvt_pk_fp8_f32(x[d0][i] * QS8, x[d0][i + 1] * QS8, r, false); r = __builtin_amdgcn_cvt_pk_fp8_f32(x[d0][i + 2] * QS8, x[d0][i + 3] * QS8, r, true); q8[ds][w] = (int)r; }
  }
}

typedef __attribute__((address_space(3))) unsigned char lds_u8;
__device__ __forceinline__ void glds16(const void* gsrc, unsigned lds_dst) { unsigned keep;
  asm volatile("s_mov_b32 %0, m0\n\ts_mov_b32 m0, %2\n\ts_nop 0\n\tglobal_load_lds_dwordx4 %1, off\n\ts_mov_b32 m0, %0" : "=&s"(keep) : "v"(gsrc), "s"(lds_dst) : "memory"); }
__device__ __forceinline__ void qkt_l(f32x16& p0, f32x16& p1, const lds_u8* Ks, const bf16x8* qr, int r32, int hi) {
  p0 = f32x16{}; p1 = f32x16{};
#pragma unroll
  for (int d0 = 0; d0 < 8; ++d0) { const int cb = (d0 * 16 + hi * 8) * 2;
    const bf16x8 b0 = *(const __attribute__((address_space(3))) bf16x8*)(Ks + KSWZ(r32, cb));
    const bf16x8 b1 = *(const __attribute__((address_space(3))) bf16x8*)(Ks + KSWZ(32 + r32, cb));
    p0 = __builtin_amdgcn_mfma_f32_32x32x16_bf16(b0, qr[d0], p0, 0, 0, 0);
    p1 = __builtin_amdgcn_mfma_f32_32x32x16_bf16(b1, qr[d0], p1, 0, 0, 0); }
}
template <int VW> constexpr int v_rd_off2(int d0, int ks, int half) { return d0 * 512 + ks * (4096 * VW) + half * (2048 * VW); }
template <int VW, int D0> __device__ __forceinline__ void pv_one2(f32x16& od, int vb, bf16x8 pa0, bf16x8 pa1, bf16x8 pa2, bf16x8 pa3) {
  const s16x4 l0 = tr_read<v_rd_off2<VW>(D0, 0, 0)>(vb), h0 = tr_read<v_rd_off2<VW>(D0, 0, 1)>(vb), l1 = tr_read<v_rd_off2<VW>(D0, 1, 0)>(vb), h1 = tr_read<v_rd_off2<VW>(D0, 1, 1)>(vb);
  const s16x4 l2 = tr_read<v_rd_off2<VW>(D0, 2, 0)>(vb), h2 = tr_read<v_rd_off2<VW>(D0, 2, 1)>(vb), l3 = tr_read<v_rd_off2<VW>(D0, 3, 0)>(vb), h3 = tr_read<v_rd_off2<VW>(D0, 3, 1)>(vb);
  asm volatile("s_waitcnt lgkmcnt(0)" ::: "memory"); SBAR();
#define PK(L, H) (bf16x8){L[0], L[1], L[2], L[3], H[0], H[1], H[2], H[3]}
  od = __builtin_amdgcn_mfma_f32_32x32x16_bf16(pa0, PK(l0, h0), od, 0, 0, 0);
  od = __builtin_amdgcn_mfma_f32_32x32x16_bf16(pa1, PK(l1, h1), od, 0, 0, 0);
  od = __builtin_amdgcn_mfma_f32_32x32x16_bf16(pa2, PK(l2, h2), od, 0, 0, 0);
  od = __builtin_amdgcn_mfma_f32_32x32x16_bf16(pa3, PK(l3, h3), od, 0, 0, 0);
#undef PK
}
template <int VW> __device__ __forceinline__ void pv_all2(f32x16* o, int vb, bf16x8 pa0, bf16x8 pa1, bf16x8 pa2, bf16x8 pa3) {
  pv_one2<VW, 0>(o[0], vb, pa0, pa1, pa2, pa3); pv_one2<VW, 1>(o[1], vb, pa0, pa1, pa2, pa3); pv_one2<VW, 2>(o[2], vb, pa0, pa1, pa2, pa3); pv_one2<VW, 3>(o[3], vb, pa0, pa1, pa2, pa3);
  if constexpr (VW == 2) { pv_one2<VW, 4>(o[4], vb, pa0, pa1, pa2, pa3); pv_one2<VW, 5>(o[5], vb, pa0, pa1, pa2, pa3); pv_one2<VW, 6>(o[6], vb, pa0, pa1, pa2, pa3); pv_one2<VW, 7>(o[7], vb, pa0, pa1, pa2, pa3); }
}
template <int VW> constexpr int dma_slot_bytes() { return 16384 + 16384 * VW; }
template <int VW> constexpr int dma_lds_bytes() { return 2 * dma_slot_bytes<VW>() + NW * 64 * 4; }
template <int VW, int LDQ, int LDK, int LDV, int LDO, int LDZ, bool GATED, int VAR = 0>
__device__ __forceinline__ void attn_dma_body(const bf16* __restrict__ Qb, const bf16* __restrict__ Kh, const bf16* __restrict__ Vh, unsigned short* __restrict__ Ob, const unsigned short* __restrict__ Zb, int seq, lds_u8* lds,
                                              const float* __restrict__ qgain, const float* __restrict__ qrope, int qt0, int wv) {
  constexpr int SLOT = dma_slot_bytes<VW>(), NVI = 2 * VW, NOPS = 2 + NVI;
  int tid = wv * 64 + hw_lane(); asm volatile("" : "+v"(tid));
  const int wid = __builtin_amdgcn_readfirstlane(tid >> 6), lane = tid & 63, r32 = lane & 31, hi = lane >> 5;
  const unsigned lbase = (unsigned)(size_t)lds;
  __attribute__((address_space(3))) float* ws = (__attribute__((address_space(3))) float*)(lds + 2 * SLOT) + wid * 64;
  __attribute__((address_space(3))) float* li_l = ws; __attribute__((address_space(3))) float* al_l = ws + 32;
  float m_reg = -1e30f, l_reg = 0; f32x16 o[4 * VW]; bf16x8 qr[8];
#pragma unroll
  for (int d = 0; d < 4 * VW; ++d) o[d] = f32x16{};
  unsigned koff[2], voff[NVI];
#pragma unroll
  for (int i = 0; i < 2; ++i) { const int ch = i * 512 + tid, row = ch >> 4, sc = ch & 15, c = sc ^ (row & 7); koff[i] = (unsigned)(row * LDK + c * 8); }
#pragma unroll
  for (int i = 0; i < NVI; ++i) { const int ch = i * 512 + tid, st = ch >> 5, kk7 = (ch >> 2) & 7, c8 = ch & 3, kg = st / (4 * VW), cblk = st % (4 * VW), kk = kg * 8 + kk7;
    const int k = (kk & ~0xC) | ((kk & 4) << 1) | ((kk & 8) >> 1); voff[i] = (unsigned)(k * LDV + cblk * 32 + c8 * 8); }
  const unsigned ldsw = lbase + (unsigned)wid * 1024u;
#define ISSUE(slot, k0) do { _Pragma("unroll") for (int _i = 0; _i < 2; ++_i) glds16(Kh + (size_t)(k0) * LDK + koff[_i], (unsigned)__builtin_amdgcn_readfirstlane(ldsw + (slot) * SLOT + _i * 8192)); \
    _Pragma("unroll") for (int _i = 0; _i < NVI; ++_i) glds16(Vh + (size_t)(k0) * LDV + voff[_i], (unsigned)__builtin_amdgcn_readfirstlane(ldsw + (slot) * SLOT + 16384 + _i * 8192)); } while (0)
#define WAITBAR(N) asm volatile("s_waitcnt vmcnt(" #N ") lgkmcnt(0)\n\ts_barrier" ::: "memory")
#define LBAR() asm volatile("s_waitcnt lgkmcnt(0)\n\ts_barrier" ::: "memory")
#define RESC(a) do { if (__any((a) < 1.f)) { if (hi == 0) al_l[r32] = (a); asm volatile("s_waitcnt lgkmcnt(0)" ::: "memory"); \
    _Pragma("unroll") for (int d = 0; d < 4 * VW; ++d) _Pragma("unroll") for (int r = 0; r < 16; ++r) o[d][r] *= al_l[crow(r, hi)]; } } while (0)
#define TILE(slot) do { if constexpr (VAR != 4) qkt_l(p0, p1, lds + (slot) * SLOT, qr, r32, hi); else { asm volatile("" : "+v"(p0), "+v"(p1)); } \
    if constexpr (VAR != 1) { partialSM(p0, p1, m_reg, mn, al); RESC(al); finishSM(p0, p1, al, l_reg, pa0, pa1, pa2, pa3); } \
    else { u32x4 w0 = {cvtpk(p0[0], p0[1]), cvtpk(p0[2], p0[3]), cvtpk(p0[4], p0[5]), cvtpk(p0[6], p0[7])}, w1 = {cvtpk(p0[8], p0[9]), cvtpk(p0[10], p0[11]), cvtpk(p0[12], p0[13]), cvtpk(p0[14], p0[15])}, \
           w2 = {cvtpk(p1[0], p1[1]), cvtpk(p1[2], p1[3]), cvtpk(p1[4], p1[5]), cvtpk(p1[6], p1[7])}, w3 = {cvtpk(p1[8], p1[9]), cvtpk(p1[10], p1[11]), cvtpk(p1[12], p1[13]), cvtpk(p1[14], p1[15])}; \
           pa0 = *reinterpret_cast<bf16x8*>(&w0); pa1 = *reinterpret_cast<bf16x8*>(&w1); pa2 = *reinterpret_cast<bf16x8*>(&w2); pa3 = *reinterpret_cast<bf16x8*>(&w3); l_reg = 1.f; } \
    SBAR(); \
    if constexpr (VAR != 2) pv_all2<VW>(o, vb0 + (slot) * SLOT, pa0, pa1, pa2, pa3); else { asm volatile("" :: "v"(pa0), "v"(pa1), "v"(pa2), "v"(pa3)); } } while (0)
  const int NT = seq / KVBLK;
  ISSUE(0, 0); ISSUE(1, KVBLK);
  const bf16* Qw = Qb + (long)(wid * QBLK + r32) * LDQ + hi * 8;
#pragma unroll
  for (int d0 = 0; d0 < 8; ++d0) qr[d0] = ld8(Qw + d0 * 16);
  q_prep(qr, qgain, qrope, qt0 + wid * QBLK + r32, hi, lane);
#pragma unroll
  for (int d0 = 0; d0 < 8; ++d0) asm volatile("" :: "v"(qr[d0]));
  const int vb0 = (int)lbase + 16384 + v_rd_base(lane);
  f32x16 p0 = {}, p1 = {}; float mn, al; bf16x8 pa0, pa1, pa2, pa3;
  for (int j = 0; j < NT; j += 2) {
    if constexpr (NOPS == 4) WAITBAR(4); else WAITBAR(6);
    TILE(0);
    LBAR();
    if (j + 2 < NT) { if constexpr (VAR != 3) ISSUE(0, (j + 2) * KVBLK); if constexpr (NOPS == 4) WAITBAR(4); else WAITBAR(6); } else WAITBAR(0);
    TILE(1);
    LBAR();
    if constexpr (VAR != 3) { if (j + 3 < NT) ISSUE(1, (j + 3) * KVBLK); }
  }
  if (hi == 0) li_l[r32] = l_reg; asm volatile("s_waitcnt lgkmcnt(0)" ::: "memory");
  float rli[16];
#pragma unroll
  for (int r = 0; r < 16; ++r) rli[r] = __builtin_amdgcn_rcpf(li_l[crow(r, hi)]);
  const bool odd = (r32 & 1) != 0; const int cpair = r32 & ~1;
  unsigned short* Ow = Ob + (long)(wid * QBLK) * LDO; const unsigned short* Zw = Zb + (long)(wid * QBLK) * LDZ;
#pragma unroll
  for (int r = 0; r < 16; r += 2) { const int orow = crow(odd ? r + 1 : r, hi);
#pragma unroll
    for (int d0 = 0; d0 < 4 * VW; ++d0) { const float a = o[d0][r] * rli[r], b = o[d0][r + 1] * rli[r + 1];
      const float recv = shx(odd ? a : b, 1, lane);
      float lo = odd ? recv : a, hi2 = odd ? b : recv;
      const long off = (long)orow * LDO + d0 * 32 + cpair;
      if constexpr (GATED) { const unsigned z = *(const unsigned*)(Zw + (long)orow * LDZ + d0 * 32 + cpair); const float z0 = __uint_as_float(z << 16), z1 = __uint_as_float(z & 0xffff0000u);
        lo *= z0 / (1.f + __expf(-z0)); hi2 *= z1 / (1.f + __expf(-z1)); }
      *(unsigned*)(Ow + off) = cvtpk(lo, hi2); } }
#undef ISSUE
#undef WAITBAR
#undef LBAR
#undef RESC
#undef TILE
}
template <int VW> constexpr int f8_slot_bytes() { return 8192 + 8192 * VW; }
template <int VW> constexpr int f8_lds_bytes() { return (VW == 1 ? 4 : 2) * f8_slot_bytes<VW>() + NW * 64 * 4 + 2048; }
template <int VW, int LDQ, int LDO, int LDZ, bool GATED>
__device__ __forceinline__ void attn_fp8_body(const bf16* __restrict__ Qb, const unsigned char* __restrict__ K8, const unsigned char* __restrict__ V8, unsigned short* __restrict__ Ob,
                                              const unsigned short* __restrict__ Zb, int seq, lds_u8* lds, const float* __restrict__ qgain, const float* __restrict__ qrope, int qt0, int wv) {
  constexpr int SLOT = f8_slot_bytes<VW>();
  constexpr float THR8 = 4.f;
  constexpr float THRL = 2.f + THR8 * 1.4426950408889634f;
  int tid = wv * 64 + hw_lane(); asm volatile("" : "+v"(tid));
  const int wid = __builtin_amdgcn_readfirstlane(tid >> 6), lane = tid & 63, r32 = lane & 31, hi = lane >> 5;
  const unsigned lbase = (unsigned)(size_t)lds;
  __attribute__((address_space(3))) float* ws = (__attribute__((address_space(3))) float*)(lds + (VW == 1 ? 4 : 2) * SLOT) + wid * 64;
  __attribute__((address_space(3))) float* li_l = ws; __attribute__((address_space(3))) float* al_l = ws + 32;
  float l_reg = 0; f32x16 o[4 * VW]; bf16x8 qr[8]; v8i32 q8[2];
  const unsigned ksrc = (unsigned)((tid >> 3) * 128 + (((tid & 7) ^ (((tid >> 3) >> 1) & 7)) << 4));
  const unsigned vsrc = (unsigned)((tid >> 2) * 64 + (((tid & 3) ^ (((tid >> 2) >> 2) & 3)) << 4));
  const unsigned ldsw = lbase + (unsigned)wid * 1024u;
#define ISSUE(slot, j) do { glds16(K8 + (size_t)(j) * 8192 + ksrc, (unsigned)__builtin_amdgcn_readfirstlane(ldsw + (slot) * SLOT)); \
    _Pragma("unroll") for (int _i = 0; _i < VW; ++_i) glds16(V8 + (size_t)(j) * (8192 * VW) + _i * 8192 + vsrc, (unsigned)__builtin_amdgcn_readfirstlane(ldsw + (slot) * SLOT + 8192 + _i * 8192)); } while (0)
#define WAITBAR(N) asm volatile("s_waitcnt vmcnt(" #N ") lgkmcnt(0)\n\ts_barrier" ::: "memory")
#define LBAR() asm volatile("s_waitcnt lgkmcnt(0)\n\ts_barrier" ::: "memory")
#define RESC(a) do { if (__any((a) < 1.f)) { if (hi == 0) al_l[r32] = (a); asm volatile("s_waitcnt lgkmcnt(0)" ::: "memory"); \
    _Pragma("unroll") for (int d = 0; d < 4 * VW; ++d) _Pragma("unroll") for (int r = 0; r < 16; ++r) o[d][r] *= al_l[crow(r, hi)]; \
    { _Pragma("unroll") for (int r = 0; r < 16; ++r) ls[r] *= al_l[crow(r, hi)]; } } } while (0)
  typedef __attribute__((address_space(3))) u32x4 lds_u32x4;
  const int fk = (r32 >> 1) & 7, gv = (r32 >> 2) & 3;
  const lds_u8* kA00 = lds + r32 * 128 + (((0 + hi * 2 + 0) ^ fk) << 4); const lds_u8* kA01 = lds + r32 * 128 + (((0 + hi * 2 + 1) ^ fk) << 4);
  const lds_u8* kA10 = lds + r32 * 128 + (((4 + hi * 2 + 0) ^ fk) << 4); const lds_u8* kA11 = lds + r32 * 128 + (((4 + hi * 2 + 1) ^ fk) << 4);
  const lds_u8* vA0 = lds + r32 * 64 + (((hi * 2 + 0) ^ gv) << 4); const lds_u8* vA1 = lds + r32 * 64 + (((hi * 2 + 1) ^ gv) << 4);
#define KFRAG(dst, slot, blk, ds) do { const u32x4 _a = *(const lds_u32x4*)(((ds) ? kA10 : kA00) + (slot) * SLOT + (blk) * 4096), _b = *(const lds_u32x4*)(((ds) ? kA11 : kA01) + (slot) * SLOT + (blk) * 4096); \
    dst = (v8i32){(int)_a.x, (int)_a.y, (int)_a.z, (int)_a.w, (int)_b.x, (int)_b.y, (int)_b.z, (int)_b.w}; } while (0)
#define VFRAG(dst, slot, cb) do { const u32x4 _a = *(const lds_u32x4*)(vA0 + (slot) * SLOT + 8192 + (cb) * 2048), _b = *(const lds_u32x4*)(vA1 + (slot) * SLOT + 8192 + (cb) * 2048); \
    dst = (v8i32){(int)_a.x, (int)_a.y, (int)_a.z, (int)_a.w, (int)_b.x, (int)_b.y, (int)_b.z, (int)_b.w}; } while (0)
#define MM8(A, B, C) __builtin_amdgcn_mfma_scale_f32_32x32x64_f8f6f4(A, B, C, 0, 0, 0, 0x7f7f7f7f, 0, 0x7f7f7f7f)
#define MMQ(A, B, C) __builtin_amdgcn_mfma_scale_f32_32x32x64_f8f6f4(A, B, C, 0, 0, 0, 0x7f7f7f7f, 0, 0x74747474)
  const unsigned kb00 = (unsigned)(size_t)kA00, kb01 = (unsigned)(size_t)kA01, kb10 = (unsigned)(size_t)kA10, kb11 = (unsigned)(size_t)kA11, vb0_ = (unsigned)(size_t)vA0, vb1_ = (unsigned)(size_t)vA1;
#define DSR(dst, base, off) asm volatile("ds_read_b128 %0, %1 offset:%2" : "=&v"(dst) : "v"(base), "i"(off) : "memory")
#define LW_(N, A, B) do { asm volatile("s_waitcnt lgkmcnt(" #N ")" : "+v"(A), "+v"(B) :: "memory"); SBAR(); } while (0)
#define F8(A, B) ((v8i32){(int)A.x, (int)A.y, (int)A.z, (int)A.w, (int)B.x, (int)B.y, (int)B.z, (int)B.w})
#define QK2(slot) do { u32x4 a0, b0, a1, b1; \
    DSR(a0, kb00, (slot) * SLOT); DSR(b0, kb01, (slot) * SLOT); DSR(a1, kb00, (slot) * SLOT + 4096); DSR(b1, kb01, (slot) * SLOT + 4096); \
    LW_(2, a0, b0); p0 = MMQ(F8(a0, b0), q8[0], cin); asm volatile("" : "+v"(p0)); LW_(0, a1, b1); p1 = MMQ(F8(a1, b1), q8[0], cin); asm volatile("" : "+v"(p1)); SBAR(); \
    DSR(a0, kb10, (slot) * SLOT); DSR(b0, kb11, (slot) * SLOT); DSR(a1, kb10, (slot) * SLOT + 4096); DSR(b1, kb11, (slot) * SLOT + 4096); \
    LW_(2, a0, b0); p0 = MMQ(F8(a0, b0), q8[1], p0); asm volatile("" : "+v"(p0)); LW_(0, a1, b1); p1 = MMQ(F8(a1, b1), q8[1], p1); asm volatile("" : "+v"(p1)); SBAR(); } while (0)
#define VRD(a, b, slot, cb) do { DSR(a, vb0_, (slot) * SLOT + 8192 + (cb) * 2048); DSR(b, vb1_, (slot) * SLOT + 8192 + (cb) * 2048); } while (0)
#define PIN(x) asm volatile("" : "+v"(x))
#define PV2(slot) do { u32x4 xa, xb, ya, yb; VRD(xa, xb, slot, 0); \
    VRD(ya, yb, slot, 1); LW_(2, xa, xb); o[0] = MM8(pf, F8(xa, xb), o[0]); PIN(o[0]); VRD(xa, xb, slot, 2); LW_(2, ya, yb); o[1] = MM8(pf, F8(ya, yb), o[1]); PIN(o[1]); \
    VRD(ya, yb, slot, 3); LW_(2, xa, xb); o[2] = MM8(pf, F8(xa, xb), o[2]); PIN(o[2]); VRD(xa, xb, slot, 4); LW_(2, ya, yb); o[3] = MM8(pf, F8(ya, yb), o[3]); PIN(o[3]); \
    VRD(ya, yb, slot, 5); LW_(2, xa, xb); o[4] = MM8(pf, F8(xa, xb), o[4]); PIN(o[4]); VRD(xa, xb, slot, 6); LW_(2, ya, yb); o[5] = MM8(pf, F8(ya, yb), o[5]); PIN(o[5]); \
    VRD(ya, yb, slot, 7); LW_(2, xa, xb); o[6] = MM8(pf, F8(xa, xb), o[6]); PIN(o[6]); DSR(xa, onesb, 0); DSR(xb, onesb, 1024); LW_(2, ya, yb); o[7] = MM8(pf, F8(ya, yb), o[7]); PIN(o[7]); \
    LW_(0, xa, xb); ls = MM8(pf, F8(xa, xb), ls); PIN(ls); SBAR(); } while (0)
#define TILE(slot, first) do { \
      \
    if constexpr (VW == 1) { v8i32 ka, kb, kc, kd; KFRAG(ka, slot, 0, 0); KFRAG(kb, slot, 1, 0); KFRAG(kc, slot, 0, 1); KFRAG(kd, slot, 1, 1); \
      p0 = MMQ(ka, q8[0], cin); p1 = MMQ(kb, q8[0], cin); p0 = MMQ(kc, q8[1], p0); p1 = MMQ(kd, q8[1], p1); } \
    else { QK2(slot); } \
      \
    { float pmax = p0[0]; _Pragma("unroll") for (int r = 1; r < 16; ++r) pmax = fmaxf(pmax, p0[r]); _Pragma("unroll") for (int r = 0; r < 16; ++r) pmax = fmaxf(pmax, p1[r]); \
      { auto rr = __builtin_amdgcn_permlane32_swap(__float_as_uint(pmax), __float_as_uint(pmax), false, false); pmax = fmaxf(__uint_as_float(rr[0]), __uint_as_float(rr[1])); } \
      if (__builtin_expect(!(first) && __all(pmax <= THRL), 1)) { al = 1.f; } \
      else { const float dm = (first) ? pmax - 2.f : fmaxf(pmax - 2.f, 0.f); al = (first) ? 1.f : __builtin_amdgcn_exp2f(-dm); \
        _Pragma("unroll") for (int r = 0; r < 16; ++r) { p0[r] -= dm; p1[r] -= dm; cin[r] -= dm; } } } \
      \
    v8i32 pf; { float ps = 0.f; \
      _Pragma("unroll") for (int w = 0; w < 4; ++w) { const float e0 = __builtin_amdgcn_exp2f(p0[4 * w]), e1 = __builtin_amdgcn_exp2f(p0[4 * w + 1]), e2 = __builtin_amdgcn_exp2f(p0[4 * w + 2]), e3 = __builtin_amdgcn_exp2f(p0[4 * w + 3]); \
        unsigned r_ = 0u; r_ = __builtin_amdgcn_cvt_pk_fp8_f32(e0, e1, r_, false); r_ = __builtin_amdgcn_cvt_pk_fp8_f32(e2, e3, r_, true); asm volatile("" : "+v"(r_)); pf[w] = (int)r_; SBAR(); } \
      _Pragma("unroll") for (int w = 0; w < 4; ++w) { const float e0 = __builtin_amdgcn_exp2f(p1[4 * w]), e1 = __builtin_amdgcn_exp2f(p1[4 * w + 1]), e2 = __builtin_amdgcn_exp2f(p1[4 * w + 2]), e3 = __builtin_amdgcn_exp2f(p1[4 * w + 3]); \
        unsigned r_ = 0u; r_ = __builtin_amdgcn_cvt_pk_fp8_f32(e0, e1, r_, false); r_ = __builtin_amdgcn_cvt_pk_fp8_f32(e2, e3, r_, true); asm volatile("" : "+v"(r_)); pf[4 + w] = (int)r_; SBAR(); } \
      } \
    SBAR(); RESC(al); SBAR();     \
    if constexpr (VW == 1) { _Pragma("unroll") for (int cb = 0; cb < 4; cb += 2) { v8i32 va, vb; VFRAG(va, slot, cb); VFRAG(vb, slot, cb + 1); o[cb] = MM8(pf, va, o[cb]); o[cb + 1] = MM8(pf, vb, o[cb + 1]); } \
      ls = MM8(pf, ones8, ls); }     \
    else { PV2(slot); } } while (0)
  const int NT = seq / KVBLK;
  ISSUE(0, 0); ISSUE(1, 1);
  const bf16* Qw = Qb + (long)(wid * QBLK + r32) * LDQ + hi * 8;
#pragma unroll
  for (int d0 = 0; d0 < 8; ++d0) qr[d0] = ld8(Qw + d0 * 16);
  q_prep<true>(qr, qgain, qrope, qt0 + wid * QBLK + r32, hi, lane, q8);
  asm volatile("" :: "v"(q8[0]), "v"(q8[1]));
#pragma unroll
  for (int d = 0; d < 4 * VW; ++d) o[d] = f32x16{};
  f32x16 p0, p1, cin, ls = f32x16{}; float al; v8i32 ones8;
  if constexpr (VW == 1) { int one = 0x38383838; asm volatile("" : "+v"(one)); _Pragma("unroll") for (int w = 0; w < 8; ++w) ones8[w] = one; }
  else { ((__attribute__((address_space(3))) unsigned*)(lds + 2 * SLOT + NW * 256))[tid] = 0x38383838u; }
  const unsigned onesb = lbase + 2 * SLOT + NW * 256 + (unsigned)lane * 16u;
#pragma unroll
  for (int r = 0; r < 16; ++r) { float two = 2.f; asm volatile("" : "+v"(two)); cin[r] = two; }
  const bool odd = (r32 & 1) != 0; const int cpair = r32 & ~1;
  unsigned short* Ow = Ob + (long)(wid * QBLK) * LDO; const unsigned short* Zw = Zb + (long)(wid * QBLK) * LDZ;
  unsigned zr[GATED ? 8 : 1][GATED ? 4 * VW : 1];
#define ZPREF() do { if constexpr (GATED) { _Pragma("unroll") for (int r = 0; r < 8; ++r) { const int orow = crow(odd ? 2 * r + 1 : 2 * r, hi); \
      _Pragma("unroll") for (int d0 = 0; d0 < 4 * VW; ++d0) zr[r][d0] = *(const unsigned*)(Zw + (long)orow * LDZ + d0 * 32 + cpair); } } } while (0)
  if (wid >= 4) __builtin_amdgcn_s_setprio(1);
  if constexpr (VW == 1) {
    v8i32 pf, pfp; u32x4 vx[4], vy[4];
#define STEP(k) do { if ((k) + 1 < NT) WAITBAR(2); else WAITBAR(0); if ((k) + 2 < NT) ISSUE(((k) + 2) & 3, (k) + 2); } while (0)
#define QK1(sl) do { v8i32 ka, kb, kc, kd; KFRAG(ka, sl, 0, 0); KFRAG(kb, sl, 1, 0); KFRAG(kc, sl, 0, 1); KFRAG(kd, sl, 1, 1); \
      p0 = MMQ(ka, q8[0], cin); p1 = MMQ(kb, q8[0], cin); p0 = MMQ(kc, q8[1], p0); p1 = MMQ(kd, q8[1], p1); PIN(p0); PIN(p1); } while (0)
#define VREAD(sl) do { const unsigned v0_ = vb0_ + (unsigned)(sl) * SLOT, v1_ = vb1_ + (unsigned)(sl) * SLOT; \
      _Pragma("unroll") for (int cb = 0; cb < 4; ++cb) { DSR(vx[cb], v0_, 8192 + (cb) * 2048); DSR(vy[cb], v1_, 8192 + (cb) * 2048); } } while (0)
#define VWAIT() asm volatile("s_waitcnt lgkmcnt(0)" : "+v"(vx[0]), "+v"(vy[0]), "+v"(vx[1]), "+v"(vy[1]), "+v"(vx[2]), "+v"(vy[2]), "+v"(vx[3]), "+v"(vy[3]) :: "memory")
#define PVM(cb) do { o[cb] = MM8(pfp, F8(vx[cb], vy[cb]), o[cb]); PIN(o[cb]); SBAR(); } while (0)
#define EXPG(pp, w, dst) do { const float e0 = __builtin_amdgcn_exp2f(pp[4 * (w)]), e1 = __builtin_amdgcn_exp2f(pp[4 * (w) + 1]), e2 = __builtin_amdgcn_exp2f(pp[4 * (w) + 2]), e3 = __builtin_amdgcn_exp2f(pp[4 * (w) + 3]); \
      unsigned r_ = 0u; r_ = __builtin_amdgcn_cvt_pk_fp8_f32(e0, e1, r_, false); r_ = __builtin_amdgcn_cvt_pk_fp8_f32(e2, e3, r_, true); asm volatile("" : "+v"(r_)); pf[dst] = (int)r_; SBAR(); } while (0)
#define SMX(first, PVON) do { \
      { float pmax = p0[0]; _Pragma("unroll") for (int r = 1; r < 16; ++r) pmax = fmaxf(pmax, p0[r]); _Pragma("unroll") for (int r = 0; r < 16; ++r) pmax = fmaxf(pmax, p1[r]); \
        { auto rr = __builtin_amdgcn_permlane32_swap(__float_as_uint(pmax), __float_as_uint(pmax), false, false); pmax = fmaxf(__uint_as_float(rr[0]), __uint_as_float(rr[1])); } \
        if (__builtin_expect(!(first) && __all(pmax <= THRL), 1)) { al = 1.f; } \
        else { const float dm = (first) ? pmax - 2.f : fmaxf(pmax - 2.f, 0.f); al = (first) ? 1.f : __builtin_amdgcn_exp2f(-dm); \
          _Pragma("unroll") for (int r = 0; r < 16; ++r) { p0[r] -= dm; p1[r] -= dm; cin[r] -= dm; } } } \
      SBAR(); if (PVON) VWAIT(); \
      EXPG(p0, 0, 0); if (PVON) PVM(0); EXPG(p0, 1, 1); EXPG(p0, 2, 2); if (PVON) PVM(1); EXPG(p0, 3, 3); \
      EXPG(p1, 0, 4); if (PVON) PVM(2); EXPG(p1, 1, 5); EXPG(p1, 2, 6); if (PVON) PVM(3); EXPG(p1, 3, 7); \
      if (PVON) { ls = MM8(pfp, ones8, ls); PIN(ls); SBAR(); } \
      RESC(al); SBAR(); \
      _Pragma("unroll") for (int w = 0; w < 8; ++w) pfp[w] = pf[w]; } while (0)
    STEP(0); QK1(0); SMX(true, 0);
    for (int k = 1; k < NT; ++k) { STEP(k); QK1(k & 3); VREAD((k - 1) & 3); SMX(false, 1); }
    ZPREF();
    VREAD((NT - 1) & 3); VWAIT(); PVM(0); PVM(1); PVM(2); PVM(3); ls = MM8(pfp, ones8, ls);
#undef STEP
#undef QK1
#undef VREAD
#undef VWAIT
#undef PVM
#undef EXPG
#undef SMX
  } else {
  for (int j = 0; j + 2 < NT; j += 2) {
    WAITBAR(3);
    TILE(0, j == 0);
    LBAR();
    ISSUE(0, j + 2); WAITBAR(3);
    TILE(1, false);
    LBAR();
    ISSUE(1, j + 3);
  }
  WAITBAR(3);
  TILE(0, NT == 2);
  WAITBAR(0);
  ZPREF();
  TILE(1, false);
  }
#undef ZPREF
  __builtin_amdgcn_s_setprio(0);
  float rli[16];
  if constexpr (true) {
#pragma unroll
    for (int r = 0; r < 16; ++r) rli[r] = 0.0625f * __builtin_amdgcn_rcpf(ls[r]);
  } else {
    if (hi == 0) li_l[r32] = l_reg; asm volatile("s_waitcnt lgkmcnt(0)" ::: "memory");
#pragma unroll
    for (int r = 0; r < 16; ++r) rli[r] = 0.0625f * __builtin_amdgcn_rcpf(li_l[crow(r, hi)]);
  }
#pragma unroll
  for (int r = 0; r < 16; r += 2) { const int orow = crow(odd ? r + 1 : r, hi);
#pragma unroll
    for (int d0 = 0; d0 < 4 * VW; ++d0) { const float a = o[d0][r] * rli[r], b = o[d0][r + 1] * rli[r + 1];
      const float recv = shx(odd ? a : b, 1, lane);
      float lo = odd ? recv : a, hi2 = odd ? b : recv;
      if constexpr (GATED) { const unsigned z = zr[r >> 1][d0]; const float z0 = __uint_as_float(z << 16), z1 = __uint_as_float(z & 0xffff0000u);
        lo *= z0 * __builtin_amdgcn_rcpf(1.f + __expf(-z0)); hi2 *= z1 * __builtin_amdgcn_rcpf(1.f + __expf(-z1)); }
      *(unsigned*)(Ow + (long)orow * LDO + d0 * 32 + cpair) = cvtpk(lo, hi2); }
    if constexpr (VW == 2) SBAR(); }
#undef ISSUE
#undef WAITBAR
#undef LBAR
#undef RESC
#undef KFRAG
#undef VFRAG
#undef MM8
#undef MMQ
#undef DSR
#undef LW_
#undef F8
#undef QK2
#undef VRD
#undef PV2
#undef PIN
#undef TILE
}
}

constexpr int DM = 4096, NB = 2, SEQ = 4096, CTXL = 256, RB = SEQ + CTXL  , RT = NB * RB  ;
constexpr int INC = 13312, KVC = 3072, MIXW = 4096, OW = 6144;
constexpr int C_KA = 0, C_VA = 512, C_KC = 1024, C_VC = 2048, C_QA = 3072, C_QC = 5120, C_XB = 6144, C_BB = 7168, C_CB = 8192, C_ZA = 9216, C_ZB = 11264, C_ZC = 12288;
constexpr float EPS = 1e-6f;
constexpr int NPHASE = 14;

constexpr size_t MiB = 1u << 20;
constexpr size_t WS_CTL = 0, CTL_ZERO_BYTES = 1 * MiB;
constexpr size_t WS_ROPE = 1 * MiB;
constexpr size_t WS_WIN = 2 * MiB;
constexpr size_t WS_WOUT = 210 * MiB;
constexpr size_t WS_NB = 274 * MiB;
constexpr size_t WS_U = 342 * MiB;
constexpr size_t WS_O = 563 * MiB;
constexpr size_t WS_MIX = 767 * MiB;
constexpr size_t WS_H1 = 835 * MiB;
constexpr size_t WS_SLAB = 971 * MiB;
constexpr size_t WS_END = 1035 * MiB;
static_assert(WS_WIN + (size_t)2 * INC * DM * 2 <= WS_WOUT && WS_WOUT + (size_t)2 * DM * DM * 2 <= WS_NB && WS_NB + (size_t)RT * DM * 2 <= WS_U && WS_U + (size_t)RT * INC * 2 <= WS_O
              && WS_O + (size_t)RT * 2048 * 2 <= WS_MIX && WS_MIX + (size_t)RT * MIXW * 2 <= WS_H1 && WS_H1 + (size_t)RT * DM * 4 <= WS_SLAB && WS_SLAB + (size_t)8 * 512 * 4096 * 4 <= WS_END, "d_ws map");
constexpr int CW_TMO = 0, CW_CODE = 1;
constexpr int CW_BAR = 4096;
constexpr int CW_MOD = 16384;
static_assert((CW_MOD + 2 * 3 * 12288) * 4 <= (int)CTL_ZERO_BYTES, "CTL words inside the memset region");

constexpr int NWAVES = 8;
constexpr int RING_OFF = 0, RING_BYTES = 139264;
constexpr int LDSCTL_OFF = RING_BYTES, MISC_OFF = LDSCTL_OFF + 320;
constexpr int LDS_BYTES = 147456;
static_assert(MISC_OFF + 128 <= LDS_BYTES && pg8::STAGE_BYTES <= RING_BYTES && (int)att::SHM_ATTN <= RING_BYTES && att::dma_lds_bytes<2>() <= RING_BYTES && att::f8_lds_bytes<2>() <= RING_BYTES && WS_O + 198 * MiB <= WS_MIX, "LDS / fp8 workspace map");

#define GAS __attribute__((address_space(1)))
#define LAS __attribute__((address_space(3)))
typedef unsigned short bf16;
typedef unsigned v4u __attribute__((ext_vector_type(4)));
typedef unsigned v2u __attribute__((ext_vector_type(2)));
typedef float f32x4 __attribute__((ext_vector_type(4)));
typedef GAS unsigned gu32;
#define RLX_AGENT __ATOMIC_RELAXED, __HIP_MEMORY_SCOPE_AGENT
#define LDS_WAIT() asm volatile("s_waitcnt lgkmcnt(0)" ::: "memory")
#define VM_WAIT() asm volatile("s_waitcnt vmcnt(0)" ::: "memory")
__device__ __forceinline__ unsigned pk2(float lo, float hi) { return pg8::cvt_pk_bf16(lo, hi); }
__device__ __forceinline__ float bflo(unsigned w) { return __uint_as_float(w << 16); }
__device__ __forceinline__ float bfhi(unsigned w) { return __uint_as_float(w & 0xffff0000u); }
__device__ __forceinline__ float silu_f(float v) { return v / (1.f + __expf(-v)); }

#define XB_TMO      128
#define XB_XCNT(j)  (256  + 64 * (j))
#define XB_XSUB(j)  (1280 + 64 * (j))
#define XB_XGEN(j)  (2304 + 64 * (j))
#define XB_TOP      3328
#define XB_TOPGEN   3392
#define XCD_BAR_WORDS 3456
#define XB_SPIN_CAP (1u << 18)
__device__ __forceinline__ unsigned xb_ld(unsigned* p)              { return __hip_atomic_load(p, __ATOMIC_RELAXED, __HIP_MEMORY_SCOPE_AGENT); }
__device__ __forceinline__ unsigned xb_add(unsigned* p, unsigned v) { return __hip_atomic_fetch_add(p, v, __ATOMIC_RELAXED, __HIP_MEMORY_SCOPE_AGENT); }
__device__ __forceinline__ unsigned xb_xcc_id() { return (unsigned)__builtin_amdgcn_s_getreg((3 << 11) | 20) & 0xFu; }
#define XB_SPIN(cond, bar) do { unsigned _sp = 0; while (cond) { __builtin_amdgcn_s_sleep(1); \
    if ((++_sp & 255u) == 0u) { if (xb_ld(&(bar)[XB_TMO])) break; if (_sp > XB_SPIN_CAP) { atomicAdd(&(bar)[XB_TMO], 1u); break; } } } } while (0)
struct XcdBarrier { unsigned* bar; unsigned x; volatile LAS unsigned* st; int wv; };
__device__ __forceinline__ XcdBarrier xcd_barrier_post(unsigned* bar, volatile LAS unsigned* st, int wv) {
    XcdBarrier b; b.bar = bar; b.x = xb_xcc_id(); b.st = st; b.wv = wv;
    if (wv == 0 && hw_lane() == 0) (void)xb_add(&bar[XB_XCNT(b.x)], 1u);
    return b;
}
__device__ __forceinline__ void xcd_barrier_complete(unsigned* bar, unsigned x, unsigned& nloc, unsigned& nx) {
    const unsigned G = gridDim.x * gridDim.y * gridDim.z;
    unsigned sum, cnt, mine, sp = 0u;
    for (;;) {
        sum = 0u; cnt = 0u; mine = 0u;
#pragma unroll
        for (unsigned j = 0; j < 16; ++j) { const unsigned c = xb_ld(&bar[XB_XCNT(j)]); sum += c; cnt += (c > 0u) ? 1u : 0u; mine = (j == x) ? c : mine; }
        if (sum == G) break;
        __builtin_amdgcn_s_sleep(1);
        if ((++sp & 255u) == 0u) { if (xb_ld(&bar[XB_TMO])) break; if (sp > XB_SPIN_CAP) { atomicAdd(&bar[XB_TMO], 1u); break; } }
    }
    nloc = mine > 0u ? mine : 1u; nx = cnt > 0u ? cnt : 1u;
}
__device__ __forceinline__ void xcd_barrier(const XcdBarrier& b) {
    asm volatile("s_waitcnt vmcnt(0)" ::: "memory");
    __syncthreads();
    if (b.wv == 0 && hw_lane() == 0) {
        unsigned* bar = b.bar;
        __builtin_amdgcn_s_waitcnt(0);
        unsigned nloc = b.st[0], nx = b.st[1];
        if (nloc == 0u) { xcd_barrier_complete(bar, b.x, nloc, nx); b.st[0] = nloc; b.st[1] = nx; }
        const unsigned old = xb_add(&bar[XB_XSUB(b.x)], 1u);
        const unsigned gen = old / nloc;
        if (old + 1u == (gen + 1u) * nloc) {
            __builtin_amdgcn_fence(__ATOMIC_RELEASE, "agent");
            asm volatile("s_waitcnt vmcnt(0)" ::: "memory");
            const unsigned og = xb_add(&bar[XB_TOP], 1u);
            const unsigned tg = og / nx;
            if (og + 1u == (tg + 1u) * nx) xb_add(&bar[XB_TOPGEN], 1u);
            else XB_SPIN(xb_ld(&bar[XB_TOPGEN]) == tg, bar);
            __builtin_amdgcn_fence(__ATOMIC_ACQUIRE, "agent");
            xb_add(&bar[XB_XGEN(b.x)], 1u);
            asm volatile("s_waitcnt vmcnt(0)" ::: "memory");
        } else {
            XB_SPIN(xb_ld(&bar[XB_XGEN(b.x)]) == gen, bar);
            __builtin_amdgcn_fence(__ATOMIC_ACQUIRE, "agent");
            asm volatile("s_waitcnt vmcnt(0)" ::: "memory");
        }
    }
    __syncthreads();
}

__device__ __forceinline__ int launder(int v) { asm volatile("" : "+v"(v)); return v; }
__device__ __forceinline__ float wave_sum(float v, int lane) {
#pragma unroll
    for (int o = 1; o < 64; o <<= 1) v += att::shx(v, o, lane);
    return v;
}

struct Args { const float* in[18]; float* out; unsigned char* ws; int ph_lo, ph_hi; };

struct TItem { const float* src; bf16* dst; int N; unsigned char* dst8; };
__device__ __forceinline__ TItem t_locate(int it, const float* w_in, const float* w_out, bf16* WIN_T, bf16* WOUT_T, unsigned char* W8) {
    constexpr int I_IN = (DM / 64) * (INC / 64), I_OUT = (DM / 64) * (DM / 64);
    TItem t; int r = it;
    if (r < 2 * I_IN) { const int l = r / I_IN; r -= l * I_IN; const int kb = r / (INC / 64), nb = r - kb * (INC / 64);
        t.src = w_in + (size_t)l * DM * INC + (size_t)(64 * kb) * INC + 64 * nb; t.dst = WIN_T + (size_t)l * INC * DM + (size_t)(64 * nb) * DM + 64 * kb; t.N = INC;
        const int tile = nb >> 2; t.dst8 = pg8::f8_tile(tile) ? W8 + ((size_t)l * (pg8::F8N * 256) + (size_t)pg8::f8_tile_index(tile) * 256 + (nb & 3) * 64) * 4096 + 64 * kb : nullptr; }
    else { r -= 2 * I_IN; const int l = r / I_OUT; r -= l * I_OUT; const int kb = r / (DM / 64), nb = r - kb * (DM / 64);
        t.src = w_out + (size_t)l * DM * DM + (size_t)(64 * kb) * DM + 64 * nb; t.dst = WOUT_T + (size_t)l * DM * DM + (size_t)(64 * nb) * DM + 64 * kb; t.N = DM; t.dst8 = nullptr; }
    return t;
}
__device__ __forceinline__ void t_load(f32x4 (&w)[16], const TItem& t, int lane) {
#pragma unroll
    for (int i = 0; i < 16; ++i) w[i] = __builtin_nontemporal_load((const f32x4*)(t.src + (size_t)(4 * i + (lane >> 4)) * t.N + 4 * (lane & 15)));
}
__device__ __forceinline__ void t_store(const f32x4 (&w)[16], bf16* dst, LAS float* scr, int lane, unsigned char* dst8 = nullptr) {
#pragma unroll
    for (int i = 0; i < 16; ++i) { const int kk = 4 * i + (lane >> 4); LAS float* d = scr + kk * 65 + 4 * (lane & 15); d[0] = w[i].x; d[1] = w[i].y; d[2] = w[i].z; d[3] = w[i].w; }
    LDS_WAIT(); asm volatile("" ::: "memory");
    const int c = lane & 7;
#pragma unroll
    for (int j = 0; j < 8; ++j) { const int n = (lane >> 3) + 8 * j; const LAS float* s = scr + (8 * c) * 65 + n;
        if (dst8) { unsigned f0 = 0u, f1 = 0u; f0 = __builtin_amdgcn_cvt_pk_fp8_f32(s[0 * 65] * 1024.f, s[1 * 65] * 1024.f, f0, false); f0 = __builtin_amdgcn_cvt_pk_fp8_f32(s[2 * 65] * 1024.f, s[3 * 65] * 1024.f, f0, true);
            f1 = __builtin_amdgcn_cvt_pk_fp8_f32(s[4 * 65] * 1024.f, s[5 * 65] * 1024.f, f1, false); f1 = __builtin_amdgcn_cvt_pk_fp8_f32(s[6 * 65] * 1024.f, s[7 * 65] * 1024.f, f1, true);
            v2u o8; o8.x = f0; o8.y = f1; *(v2u*)(dst8 + (size_t)n * 4096 + 8 * c) = o8; }
        else { v4u o; o.x = pk2(s[0 * 65], s[1 * 65]); o.y = pk2(s[2 * 65], s[3 * 65]); o.z = pk2(s[4 * 65], s[5 * 65]); o.w = pk2(s[6 * 65], s[7 * 65]);
        *(v4u*)(dst + (size_t)n * DM + 8 * c) = o; } }
    LDS_WAIT(); asm volatile("" ::: "memory");
}

__global__ void __launch_bounds__(NWAVES * 64, 2) mk_fwd(Args args) {
    extern __shared__ __attribute__((aligned(16))) unsigned char lds[];
    LAS unsigned char* ldsl = (LAS unsigned char*)lds;
    volatile LAS unsigned* MISC = (volatile LAS unsigned*)(ldsl + MISC_OFF);
    const int wave = __builtin_amdgcn_readfirstlane((int)threadIdx.x >> 6);
    const int G = gridDim.x; const int bx = blockIdx.x;
    const int vcu = (G % 8 == 0) ? (bx % 8) * (G / 8) + bx / 8 : bx;
    const int gw = vcu * NWAVES + wave, NGW = G * NWAVES;
    unsigned char* ws = args.ws;
    gu32* ctl = (gu32*)(ws + WS_CTL);
    const float* x = args.in[0]; const float* cvec = args.in[1]; const float* ctxin = args.in[2]; const float* cctx = args.in[3];
    const float* w_mod = args.in[4]; const float* b_mod = args.in[5]; const float* norm_g = args.in[6]; const float* w_in = args.in[7];
    const float* q_norm_a = args.in[8]; const float* k_norm_a = args.in[9]; const float* conv_w = args.in[10];
    const float* lq1 = args.in[11]; const float* lk1 = args.in[12]; const float* lq2 = args.in[13]; const float* lk2 = args.in[14];
    const float* subln_g = args.in[15]; const float* w_out = args.in[16]; const float* final_g = args.in[17];
    float* outp = args.out;
    float* MOD = (float*)(ws + WS_CTL) + CW_MOD;
    float* ROPE = (float*)(ws + WS_ROPE);
    bf16* WIN_T = (bf16*)(ws + WS_WIN); bf16* WOUT_T = (bf16*)(ws + WS_WOUT);
    bf16* NBUF = (bf16*)(ws + WS_NB); bf16* U = (bf16*)(ws + WS_U); bf16* OCB = (bf16*)(ws + WS_O); unsigned char* K8 = ws + WS_O + 40 * MiB; unsigned char* V8 = ws + WS_O + 48 * MiB; unsigned char* K8C = ws + WS_O + 56 * MiB; unsigned char* V8C = ws + WS_O + 66 * MiB; unsigned char* NB8 = ws + WS_O + 80 * MiB; unsigned char* W8 = ws + WS_O + 116 * MiB;         bf16* MIX = (bf16*)(ws + WS_MIX); bf16* DL = (bf16*)(ws + WS_H1); float* SLAB = (float*)(ws + WS_SLAB);

    for (int u = wave * 64 + hw_lane(); u < (LDS_BYTES - LDSCTL_OFF) / 4; u += NWAVES * 64) ((LAS unsigned*)(ldsl + LDSCTL_OFF))[u] = 0u;
    __syncthreads();
    XcdBarrier bar; bar.bar = (unsigned*)(ctl + CW_BAR); bar.x = 0; bar.st = nullptr;
    if (!MK_PER_PHASE) bar = xcd_barrier_post((unsigned*)(ctl + CW_BAR), MISC + 8, wave);
    const int lo = args.ph_lo, hi = args.ph_hi;
#define IN(k) (lo <= (k) && (k) < hi)
#define SEAM(k) do { if (IN(k) && IN((k) + 1)) xcd_barrier(bar); } while (0)
#define REPS(k) (((MK_REP >> (k)) & 1) + 1)
#define REPBAR(k) do { if (REPS(k) > 1 && rep + 1 < REPS(k)) xcd_barrier(bar); } while (0)

    if (IN(0)) for (int rep = 0; rep < REPS(0); ++rep) {
        const int lane = hw_lane(); const int tid = wave * 64 + lane;
        float* MODw = MOD + rep * 2 * 3 * 12288;
        {
            LAS float* sl = (LAS float*)(ldsl);
            for (int e = tid; e < 3 * 4096; e += NWAVES * 64) { const int r = e >> 12, k = e & 4095; const float v = (r < 2) ? cvec[r * 4096 + k] : cctx[k]; sl[e] = silu_f(v); }
            __syncthreads();
            LAS float* red = (LAS float*)(ldsl + 49152);
            for (int it = bx; it < 768; it += G) {
                const int layer = it / 384, rem = it - layer * 384, slab = rem >> 3, kc = rem & 7;
                const int col0 = slab * 256 + lane * 4, k0 = kc * 512 + wave * 64;
                const float* W = w_mod + (size_t)layer * 4096 * 12288 + (size_t)k0 * 12288 + col0;
                f32x4 a0 = {0.f, 0.f, 0.f, 0.f}, a1 = a0, a2 = a0;
                f32x4 wA[8], wB[8];
#pragma unroll
                for (int i = 0; i < 8; ++i) wA[i] = __builtin_nontemporal_load((const f32x4*)(W + (size_t)i * 12288));
                for (int kk = 0; kk < 64; kk += 16) {
#pragma unroll
                    for (int i = 0; i < 8; ++i) wB[i] = __builtin_nontemporal_load((const f32x4*)(W + (size_t)(kk + 8 + i) * 12288));
#pragma unroll
                    for (int i = 0; i < 8; ++i) { const float s0 = sl[k0 + kk + i], s1 = sl[4096 + k0 + kk + i], s2 = sl[8192 + k0 + kk + i];
                        a0 += wA[i] * s0; a1 += wA[i] * s1; a2 += wA[i] * s2; }
                    if (kk + 16 < 64) {
#pragma unroll
                        for (int i = 0; i < 8; ++i) wA[i] = __builtin_nontemporal_load((const f32x4*)(W + (size_t)(kk + 16 + i) * 12288));
                    }
#pragma unroll
                    for (int i = 0; i < 8; ++i) { const float s0 = sl[k0 + kk + 8 + i], s1 = sl[4096 + k0 + kk + 8 + i], s2 = sl[8192 + k0 + kk + 8 + i];
                        a0 += wB[i] * s0; a1 += wB[i] * s1; a2 += wB[i] * s2; }
                }
                *(LAS f32x4*)(red + (wave * 3 + 0) * 256 + lane * 4) = a0;
                *(LAS f32x4*)(red + (wave * 3 + 1) * 256 + lane * 4) = a1;
                *(LAS f32x4*)(red + (wave * 3 + 2) * 256 + lane * 4) = a2;
                __syncthreads();
                for (int e = tid; e < 768; e += NWAVES * 64) { const int r = e >> 8, c = e & 255; float s = 0.f;
#pragma unroll
                    for (int w8 = 0; w8 < 8; ++w8) s += red[(w8 * 3 + r) * 256 + c];
                    if (kc == 0) s += b_mod[layer * 12288 + slab * 256 + c];
                    atomicAdd(MODw + (layer * 3 + r) * 12288 + slab * 256 + c, s); }
                __syncthreads();
            }
        }
        for (int e = gw * 64 + lane; e < 2048; e += NGW * 64) { const int pos = e >> 5, j = e & 31; const float inv = powf(10000.f, -(float)j / 32.f); const float a = (float)pos * inv;
            ROPE[e] = cosf(a); ROPE[2048 + e] = sinf(a); }
        {
            LAS float* scr = (LAS float*)(ldsl + wave * (64 * 65 * 4));
            constexpr int NIT = 2 * ((DM / 64) * (INC / 64));
            f32x4 wa[16], wb[16]; TItem ta, tb; int it = gw;
            if (it < NIT) { ta = t_locate(it, w_in, w_out, WIN_T, WOUT_T, W8); t_load(wa, ta, lane); }
            while (it < NIT) {
                if (it + NGW < NIT) { tb = t_locate(it + NGW, w_in, w_out, WIN_T, WOUT_T, W8); t_load(wb, tb, lane); }
                t_store(wa, ta.dst, scr, lane, ta.dst8);
                it += NGW; if (it >= NIT) break;
                if (it + NGW < NIT) { ta = t_locate(it + NGW, w_in, w_out, WIN_T, WOUT_T, W8); t_load(wa, ta, lane); }
                t_store(wb, tb.dst, scr, lane, tb.dst8);
                it += NGW;
            }
        }
        __syncthreads();
        REPBAR(0);
    }
    SEAM(0);

    for (int layer = 0; layer < 2; ++layer) {
        const int pb = 1 + 6 * layer;
        const float* modL = MOD + layer * 3 * 12288;
        if (IN(pb + 0)) for (int rep = 0; rep < REPS(1); ++rep) {
            const int lane = hw_lane();
            const float* g = norm_g + layer * 4096;
            {
                LAS f32x4* av = (LAS f32x4*)ldsl;
                for (int e = wave * 64 + lane; e < 3 * 1024; e += NWAVES * 64) { const int c = e >> 10, k4 = e & 1023; const float* mr = modL + c * 12288;
                    const f32x4 gg = ((const f32x4*)g)[k4], sh = ((const f32x4*)mr)[k4], sc = ((const f32x4*)(mr + 4096))[k4];
                    av[(c * 2) * 1024 + k4] = gg * (sc + 1.f); av[(c * 2 + 1) * 1024 + k4] = sh; }
                __syncthreads();
            }
            for (int r = gw; r < RT; r += NGW) {
                const int b = r / RB, p = r - b * RB; const bool isctx = p < CTXL;
                const float* src = isctx ? ctxin + ((size_t)b * CTXL + p) * DM : x + ((size_t)b * SEQ + (p - CTXL)) * DM;
                const LAS f32x4* a4 = (const LAS f32x4*)ldsl + ((isctx ? 2 : b) * 2) * 1024;
                const f32x4* s4 = (const f32x4*)src + lane;
                f32x4 v[16]; float ss = 0.f;
                if (layer == 1 && isctx) {
                    const f32x4* g4 = (const f32x4*)(MOD + 2 * 12288 + 8192) + lane; const f32x4* sl4 = (const f32x4*)(SLAB + ((size_t)b * 256 + p) * 4096) + lane;
#pragma unroll
                    for (int j = 0; j < 16; ++j) { f32x4 a = sl4[64 * j];
#pragma unroll
                        for (int ks = 1; ks < 8; ++ks) a += sl4[(size_t)ks * 512 * 1024 + 64 * j];
                        v[j] = s4[64 * j] + g4[64 * j] * a; }
                } else if (layer == 1) {
                    const v2u* d2 = (const v2u*)(DL + (size_t)r * DM) + lane;
#pragma unroll
                    for (int j = 0; j < 16; ++j) { const v2u d = d2[64 * j]; v[j] = s4[64 * j] + (f32x4){bflo(d.x), bfhi(d.x), bflo(d.y), bfhi(d.y)}; }
                } else {
#pragma unroll
                    for (int j = 0; j < 16; ++j) v[j] = s4[64 * j];
                }
#pragma unroll
                for (int j = 0; j < 16; ++j) ss += (v[j].x * v[j].x + v[j].y * v[j].y) + (v[j].z * v[j].z + v[j].w * v[j].w);
                const float rstd = 1.f / sqrtf(wave_sum(ss, lane) * (1.f / DM) + EPS);
                v2u* o2 = (v2u*)(NBUF + (size_t)r * DM) + lane;
#pragma unroll
                for (int j = 0; j < 16; ++j) { const int ci = lane + 64 * j;
                    const f32x4 y = v[j] * rstd * a4[ci] + a4[1024 + ci];
                    v2u o; o.x = pk2(y.x, y.y); o.y = pk2(y.z, y.w); o2[64 * j] = o;
                    unsigned f = 0u; f = __builtin_amdgcn_cvt_pk_fp8_f32(y.x * 16.f, y.y * 16.f, f, false); f = __builtin_amdgcn_cvt_pk_fp8_f32(y.z * 16.f, y.w * 16.f, f, true);
                    ((unsigned*)(NB8 + (size_t)r * 4096))[ci] = f; }
            }
            __syncthreads();
            REPBAR(1);
        }
        SEAM(pb + 0);
        if (IN(pb + 1)) for (int rep = 0; rep < REPS(2); ++rep) {
            pg8::Gemm g{NBUF, WIN_T + (size_t)layer * INC * DM, DM, DM, DM, NB8, W8 + (size_t)layer * (pg8::F8N * 256) * 4096};
            int bxl = bx; asm volatile("" : "+s"(bxl));
            pg8::EpiBf16 E{U, INC};
            const int Mrows = (layer == 1) ? NB * SEQ : RT;
            const int bxr = G - 1 - bxl;
            pg8::RowMapOrder S; S.latent_only = (layer == 1); S.ctx_ntiles = (layer == 1) ? 4 : 0; S.colmap = 2; S.so.init(Mrows, pg8::BFN * 256, G, bxr);
            int first_idle; { const int nunits = S.so.nwg + 2 * S.ctx_ntiles, rounds = (nunits + G - 1) / G; first_idle = nunits - (rounds - 1) * G; asm volatile("" : "+s"(first_idle)); }
            int Gf = (layer == 1 && first_idle < G / 4) ? G - first_idle : G; asm volatile("" : "+s"(Gf));
            const int n8 = (Mrows / 256) * pg8::F8N + ((layer == 1) ? 16 : 0);
            const int light_lo = n8 % Gf, light_hi = Gf;
            if (bxl < Gf) { pg8::RowMapOrder S8; S8.latent_only = (layer == 1); S8.ctx_ntiles = (layer == 1) ? 8 : 0; S8.colmap = 1; S8.so.init(Mrows, pg8::F8N * 256, Gf, bxl);
              pg8::gemm_phase<pg8::EpiBf16, pg8::RowMapOrder, false, true, true>(ldsl + RING_OFF, g, S8, E, wave); }
            pg8::gemm_phase<pg8::EpiBf16, pg8::RowMapOrder, false, true, false>(ldsl + RING_OFF, g, S, E, wave);
            {
                const int lane = hw_lane();
                constexpr int I_IN2 = 2 * (DM / 64) * (INC / 64), I_OUT = (DM / 64) * (DM / 64);
                const bool helper = (Gf < G) ? (bxl >= light_lo && bxl < light_hi) : ((first_idle < G) && (bxr >= first_idle));
                const int nh = (Gf < G) ? (light_hi - light_lo) * NWAVES : helper ? (G - first_idle) * NWAVES : G * NWAVES;
                const int hr = (Gf < G) ? (bxl - light_lo) * NWAVES + wave : helper ? (bxr - first_idle) * NWAVES + wave : bxr * NWAVES + wave;
                if (helper || first_idle >= G) {
                    LAS float* scr = (LAS float*)(ldsl + wave * (64 * 65 * 4));
                    for (int it = hr; it < I_OUT; it += nh) { f32x4 wa[16]; const TItem ta = t_locate(I_IN2 + layer * I_OUT + it, w_in, w_out, WIN_T, WOUT_T, W8); t_load(wa, ta, lane); t_store(wa, ta.dst, scr, lane, ta.dst8); }
                }
            }
            REPBAR(2);
        }
        SEAM(pb + 1);
        if (IN(pb + 2)) for (int rep = 0; rep < REPS(3); ++rep) {
            const int lane = hw_lane();
            const size_t wr_off = rep ? (size_t)(WS_END - WS_U) / 2 : 0;
            const float* qn = q_norm_a + layer * 128; const float* kn = k_norm_a + layer * 128; const float* cw = conv_w + layer * 3 * 1024;
            const int nitems = RT * 11;
            for (int it = gw; it < nitems; it += NGW) {
                const int r = it / 11, sub = it - r * 11;
                const int b = r / RB, p = r - b * RB; const bool isctx = p < CTXL; const int t = isctx ? p : p - CTXL;
                if (layer == 1 && isctx && sub >= 3) continue;
                if (sub >= 3 && sub < 9) continue;
                bf16* urow = U + (size_t)r * INC;
                if (sub < 9) {
                    const int cbase = (sub == 0) ? C_KA : (sub < 3) ? C_KC + (sub - 1) * 512 : (sub < 7) ? C_QA + (sub - 3) * 512 : C_QC + (sub - 7) * 512;
                    const bool donorm = (sub == 0) || (sub >= 3 && sub < 7);
                    const float* gn = (sub == 0) ? kn : qn;
                    v4u* ptr = (v4u*)(urow + cbase + lane * 8);
                    const v4u raw = *ptr;
                    float xv[8] = {bflo(raw.x), bfhi(raw.x), bflo(raw.y), bfhi(raw.y), bflo(raw.z), bfhi(raw.z), bflo(raw.w), bfhi(raw.w)};
                    const int d0 = (lane & 15) * 8;
                    if (donorm) {
                        float ss = 0.f;
#pragma unroll
                        for (int i = 0; i < 8; ++i) ss += xv[i] * xv[i];
                        ss += att::shx(ss, 1, lane); ss += att::shx(ss, 2, lane); ss += att::shx(ss, 4, lane); ss += att::shx(ss, 8, lane);
                        const float rstd = 1.f / sqrtf(ss * (1.f / 128.f) + EPS);
                        const f32x4 g0 = *(const f32x4*)(gn + d0), g1 = *(const f32x4*)(gn + d0 + 4);
                        xv[0] *= rstd * g0.x; xv[1] *= rstd * g0.y; xv[2] *= rstd * g0.z; xv[3] *= rstd * g0.w;
                        xv[4] *= rstd * g1.x; xv[5] *= rstd * g1.y; xv[6] *= rstd * g1.z; xv[7] *= rstd * g1.w;
                    }
                    if (!isctx) {
                        const int pos = (d0 < 64) ? (t >> 6) : (t & 63); const int j0 = d0 & 31; const bool first = (d0 & 32) == 0;
                        const f32x4 c0 = *(const f32x4*)(ROPE + pos * 32 + j0), c1 = *(const f32x4*)(ROPE + pos * 32 + j0 + 4);
                        const f32x4 s0 = *(const f32x4*)(ROPE + 2048 + pos * 32 + j0), s1 = *(const f32x4*)(ROPE + 2048 + pos * 32 + j0 + 4);
                        const float cs[8] = {c0.x, c0.y, c0.z, c0.w, c1.x, c1.y, c1.z, c1.w}; const float sn[8] = {s0.x, s0.y, s0.z, s0.w, s1.x, s1.y, s1.z, s1.w};
#pragma unroll
                        for (int i = 0; i < 8; ++i) { const float pr = att::shx(xv[i], 4, lane); xv[i] = first ? (xv[i] * cs[i] - pr * sn[i]) : (xv[i] * cs[i] + pr * sn[i]); }
                    }
                    if (sub < 3) {
                        const int j = lane & 15, s0 = (j >> 3) * 64 + (j & 1) * 32 + ((j >> 1) & 3) * 8; unsigned w0 = 0u, w1 = 0u;
                        w0 = __builtin_amdgcn_cvt_pk_fp8_f32(xv[0] * 16.f, xv[1] * 16.f, w0, false); w0 = __builtin_amdgcn_cvt_pk_fp8_f32(xv[2] * 16.f, xv[3] * 16.f, w0, true);
                        w1 = __builtin_amdgcn_cvt_pk_fp8_f32(xv[4] * 16.f, xv[5] * 16.f, w1, false); w1 = __builtin_amdgcn_cvt_pk_fp8_f32(xv[6] * 16.f, xv[7] * 16.f, w1, true);
                        unsigned char* kdst = (sub == 0) ? K8 + ((size_t)(b * 4 + (lane >> 4)) * RB + p) * 128 : K8C + ((size_t)(b * 8 + (sub - 1) * 4 + (lane >> 4)) * RB + p) * 128;
                        v2u o8; o8.x = w0; o8.y = w1; *(v2u*)(kdst + s0) = o8;
                        continue; }
                    v4u o; o.x = pk2(xv[0], xv[1]); o.y = pk2(xv[2], xv[3]); o.z = pk2(xv[4], xv[5]); o.w = pk2(xv[6], xv[7]);
                    if (donorm || !isctx) *(ptr + wr_off / 8) = o;
                } else {
                    const int ch = (sub - 9) * 512 + lane * 8; const int T = isctx ? CTXL : SEQ;
                    const v4u xb = *(const v4u*)(urow + C_XB + ch), bb = *(const v4u*)(urow + C_BB + ch), cb = *(const v4u*)(urow + C_CB + ch), zb = *(const v4u*)(urow + C_ZB + ch);
                    v4u xp = {0u, 0u, 0u, 0u}, cp = xp, xn = xp, cn = xp;
                    if (t > 0) { xp = *(const v4u*)(urow - INC + C_XB + ch); cp = *(const v4u*)(urow - INC + C_CB + ch); }
                    if (t < T - 1) { xn = *(const v4u*)(urow + INC + C_XB + ch); cn = *(const v4u*)(urow + INC + C_CB + ch); }
                    const f32x4 w0a = *(const f32x4*)(cw + ch), w0b = *(const f32x4*)(cw + ch + 4), w1a = *(const f32x4*)(cw + 1024 + ch), w1b = *(const f32x4*)(cw + 1024 + ch + 4),
                                w2a = *(const f32x4*)(cw + 2048 + ch), w2b = *(const f32x4*)(cw + 2048 + ch + 4);
                    const float w0[8] = {w0a.x, w0a.y, w0a.z, w0a.w, w0b.x, w0b.y, w0b.z, w0b.w}, w1[8] = {w1a.x, w1a.y, w1a.z, w1a.w, w1b.x, w1b.y, w1b.z, w1b.w},
                                w2[8] = {w2a.x, w2a.y, w2a.z, w2a.w, w2b.x, w2b.y, w2b.z, w2b.w};
                    const unsigned xbw[4] = {xb.x, xb.y, xb.z, xb.w}, bbw[4] = {bb.x, bb.y, bb.z, bb.w}, cbw[4] = {cb.x, cb.y, cb.z, cb.w}, zbw[4] = {zb.x, zb.y, zb.z, zb.w},
                                   xpw[4] = {xp.x, xp.y, xp.z, xp.w}, cpw[4] = {cp.x, cp.y, cp.z, cp.w}, xnw[4] = {xn.x, xn.y, xn.z, xn.w}, cnw[4] = {cn.x, cn.y, cn.z, cn.w};
                    float y[8];
#pragma unroll
                    for (int i = 0; i < 4; ++i) {
                        { const float conv = bflo(cpw[i]) * bflo(xpw[i]) * w0[2 * i] + bflo(cbw[i]) * bflo(xbw[i]) * w1[2 * i] + bflo(cnw[i]) * bflo(xnw[i]) * w2[2 * i];
                          y[2 * i] = bflo(bbw[i]) * conv * silu_f(bflo(zbw[i])); }
                        { const float conv = bfhi(cpw[i]) * bfhi(xpw[i]) * w0[2 * i + 1] + bfhi(cbw[i]) * bfhi(xbw[i]) * w1[2 * i + 1] + bfhi(cnw[i]) * bfhi(xnw[i]) * w2[2 * i + 1];
                          y[2 * i + 1] = bfhi(bbw[i]) * conv * silu_f(bfhi(zbw[i])); }
                    }
                    v4u o; o.x = pk2(y[0], y[1]); o.y = pk2(y[2], y[3]); o.z = pk2(y[4], y[5]); o.w = pk2(y[6], y[7]);
                    *(v4u*)(MIX + (size_t)r * MIXW + 2048 + ch) = o;
                }
            }
            {
                LAS unsigned char* scr = ldsl + wave * 16384;
                const int k = lane, blk = k >> 5, kk = k & 31, pos = ((kk >> 2) & 1) * 32 + blk * 16 + (kk >> 3) * 4 + (kk & 3);
                const int ntile = (layer == 1) ? NB * 4 * 68 : NB * 4 * 68;
                for (int it = gw; it < ntile; it += NGW) {
                    const int bk = it / 68, j = it - bk * 68, b = bk >> 2, kvh = bk & 3;
                    const bf16* src = U + (size_t)(b * RB + j * 64 + k) * INC + C_VA + kvh * 128;
#pragma unroll
                    for (int c = 0; c < 16; ++c) { const v4u raw = *(const v4u*)(src + c * 8); const unsigned rw[4] = {raw.x, raw.y, raw.z, raw.w};
#pragma unroll
                        for (int e = 0; e < 4; ++e) { unsigned f = 0u; f = __builtin_amdgcn_cvt_pk_fp8_f32(bflo(rw[e]) * 16.f, bfhi(rw[e]) * 16.f, f, false);
                            scr[(c * 8 + 2 * e) * 64 + pos] = (unsigned char)(f & 0xffu); scr[(c * 8 + 2 * e + 1) * 64 + pos] = (unsigned char)((f >> 8) & 0xffu); } }
                    LDS_WAIT(); asm volatile("" ::: "memory");
                    unsigned char* dst = V8 + ((size_t)bk * 68 + j) * 8192;
#pragma unroll
                    for (int c = 0; c < 8; ++c) *(v4u*)(dst + c * 1024 + lane * 16) = *(const LAS v4u*)(scr + c * 1024 + lane * 16);
                    LDS_WAIT(); asm volatile("" ::: "memory");
                }
                LAS unsigned char* scr2 = ldsl + wave * 16384;
                for (int it = gw; it < ntile; it += NGW) {
                    const int bk = it / 68, j = it - bk * 68, b = bk >> 2, h = bk & 3;
                    const bf16* src = U + (size_t)(b * RB + j * 64 + k) * INC + C_VC + h * 256;
#pragma unroll 4
                    for (int c = 0; c < 32; ++c) { const v4u raw = *(const v4u*)(src + c * 8); const unsigned rw[4] = {raw.x, raw.y, raw.z, raw.w};
#pragma unroll
                        for (int e = 0; e < 4; ++e) { unsigned f = 0u; f = __builtin_amdgcn_cvt_pk_fp8_f32(bflo(rw[e]) * 16.f, bfhi(rw[e]) * 16.f, f, false);
                            scr2[(c * 8 + 2 * e) * 64 + pos] = (unsigned char)(f & 0xffu); scr2[(c * 8 + 2 * e + 1) * 64 + pos] = (unsigned char)((f >> 8) & 0xffu); } }
                    LDS_WAIT(); asm volatile("" ::: "memory");
                    unsigned char* dst = V8C + ((size_t)bk * 68 + j) * 16384;
#pragma unroll
                    for (int c = 0; c < 16; ++c) *(v4u*)(dst + c * 1024 + lane * 16) = *(const LAS v4u*)(scr2 + c * 1024 + lane * 16);
                    LDS_WAIT(); asm volatile("" ::: "memory");
                }
            }
            REPBAR(3);
        }
        SEAM(pb + 2);
        if (IN(pb + 3)) for (int rep = 0; rep < REPS(4); ++rep) {
            const int nun = 768 + (layer == 0 ? 48 : 0);
            int vcl = vcu; asm volatile("" : "+s"(vcl));
            const att::bf16* Ub = (const att::bf16*)U;
            for (int L = vcl; L < nun; L += G) {
                int b, hd, qrow0, seq; bool diff;
                if (L < 512) { b = L >> 8; hd = (L >> 4) & 15; qrow0 = b * RB + CTXL + (L & 15) * 256; seq = RB; diff = false; }
                else if (L < 768) { const int w = L - 512; b = w >> 7; hd = (w >> 4) & 7; qrow0 = b * RB + CTXL + (w & 15) * 256; seq = RB; diff = true; }
                else { const int c = L - 768; seq = CTXL; if (c < 32) { b = c >> 4; hd = c & 15; diff = false; } else { b = (c - 32) >> 3; hd = (c - 32) & 7; diff = true; } qrow0 = b * RB; }
                const float* qn = q_norm_a + layer * 128; const float* qrp = (seq == RB) ? ROPE : nullptr; const int qt0 = qrow0 - b * RB - CTXL;
                if (!diff) {
                    const att::bf16* q = Ub + (size_t)qrow0 * INC + C_QA + hd * 128;
                    bf16* o = (rep ? (bf16*)(ws + WS_END) : MIX) + (size_t)qrow0 * MIXW + hd * 128; const bf16* z = U + (size_t)qrow0 * INC + C_ZA + hd * 128;
                    att::attn_fp8_body<1, INC, MIXW, INC, true>(q, K8 + (size_t)(b * 4 + (hd >> 2)) * RB * 128, V8 + (size_t)(b * 4 + (hd >> 2)) * 68 * 8192, o, z, seq, (att::lds_u8*)ldsl, qn, qrp, qt0, wave);
                } else {
                    const att::bf16* q = Ub + (size_t)qrow0 * INC + C_QC + hd * 128;
                    bf16* o = (rep ? (bf16*)(ws + WS_END) + (size_t)RT * MIXW : OCB) + (size_t)qrow0 * 2048 + hd * 256;
                    att::attn_fp8_body<2, INC, 2048, INC, false>(q, K8C + (size_t)(b * 8 + hd) * RB * 128, V8C + (size_t)(b * 4 + (hd >> 1)) * 68 * 16384, o, o, seq, (att::lds_u8*)ldsl, nullptr, qrp, qt0, wave);
                }
                __syncthreads();
            }
            REPBAR(4);
        }
        SEAM(pb + 3);
        if (IN(pb + 4)) for (int rep = 0; rep < REPS(5); ++rep) {
            const int lane = hw_lane();
            int lyr = layer; asm volatile("" : "+s"(lyr));
            unsigned u08 = 0x3f4ccccdu; asm volatile("" : "+s"(u08));
            const float l_init = __uint_as_float(u08) - 0.6f * expf(-0.3f * (float)lyr);
            float lam;
            { const float* a1 = lq1 + lyr * 128; const float* b1 = lk1 + lyr * 128; const float* a2 = lq2 + lyr * 128; const float* b2 = lk2 + lyr * 128;
              const float s1 = wave_sum(a1[lane] * b1[lane] + a1[lane + 64] * b1[lane + 64], lane); const float s2 = wave_sum(a2[lane] * b2[lane] + a2[lane + 64] * b2[lane + 64], lane);
              lam = expf(s1) - expf(s2) + l_init; }
            const float* sg = subln_g + lyr * 256;
            const f32x4 sg4 = *(const f32x4*)(sg + lane * 4);
            for (int r = gw; r < RT; r += NGW) {
                const int b = r / RB, p = r - b * RB; if (layer == 1 && p < CTXL) continue;
                const bf16* orow = OCB + (size_t)r * 2048; const bf16* urow = U + (size_t)r * INC; bf16* mrow = MIX + (size_t)r * MIXW;
#pragma unroll
                for (int h = 0; h < 4; ++h) { const int e = lane * 4;
                    const v2u a0 = *(const v2u*)(orow + (h * 2 + 0) * 256 + e), a1 = *(const v2u*)(orow + (h * 2 + 1) * 256 + e);
                    const f32x4 o0 = {bflo(a0.x), bfhi(a0.x), bflo(a0.y), bfhi(a0.y)}, o1 = {bflo(a1.x), bfhi(a1.x), bflo(a1.y), bfhi(a1.y)};
                    const f32x4 d = o0 - o1 * lam;
                    const float ss = wave_sum((d.x * d.x + d.y * d.y) + (d.z * d.z + d.w * d.w), lane);
                    const float rstd = 1.f / sqrtf(ss * (1.f / 256.f) + EPS) * (1.f - l_init);
                    const v2u z = *(const v2u*)(urow + C_ZC + h * 256 + e);
                    v2u o; o.x = pk2(d.x * rstd * sg4.x * silu_f(bflo(z.x)), d.y * rstd * sg4.y * silu_f(bfhi(z.x)));
                    o.y = pk2(d.z * rstd * sg4.z * silu_f(bflo(z.y)), d.w * rstd * sg4.w * silu_f(bfhi(z.y)));
                    *(v2u*)(mrow + 3072 + h * 256 + e) = o; }
            }
            REPBAR(5);
        }
        SEAM(pb + 4);
        if (IN(pb + 5)) for (int rep = 0; rep < REPS(6); ++rep) {
            pg8::Gemm g{MIX, WOUT_T + (size_t)layer * DM * DM, DM, DM, DM};
            int bxl = bx; asm volatile("" : "+s"(bxl));
            pg8::RowMapOrder S; S.latent_only = 1; S.ctx_ntiles = 0; S.so.init(NB * SEQ, DM, G, bxl);
            pg8::EpiGate E{DL + (size_t)layer * RT * DM, modL};
            pg8::gemm_phase<pg8::EpiGate, pg8::RowMapOrder, false, true>(ldsl + RING_OFF, g, S, E, wave);
            if (layer == 0) {
                pg8::Gemm g2{MIX, WOUT_T, DM, DM, 512};
                pg8::CtxSplitOrder S2{G, bxl};
                pg8::EpiSlab E2{SLAB};
                pg8::gemm_phase<pg8::EpiSlab, pg8::CtxSplitOrder, true, true>(ldsl + RING_OFF, g2, S2, E2, wave);
            }
            REPBAR(6);
        }
        SEAM(pb + 5);
    }
    if (IN(13)) for (int rep = 0; rep < REPS(7); ++rep) {
        const int lane = hw_lane();
        { LAS f32x4* gv = (LAS f32x4*)ldsl; for (int e = wave * 64 + lane; e < 1024; e += NWAVES * 64) gv[e] = ((const f32x4*)final_g)[e]; __syncthreads(); }
        for (int ro = gw; ro < NB * SEQ; ro += NGW) {
            const int b = ro >> 12, r = ro + (b + 1) * CTXL;
            const f32x4* s4 = (const f32x4*)(x + (size_t)ro * DM) + lane; const v2u* d0 = (const v2u*)(DL + (size_t)r * DM) + lane; const v2u* d1 = (const v2u*)(DL + (size_t)(RT + r) * DM) + lane;
            f32x4* d4 = (f32x4*)((rep ? (float*)(ws + WS_END) : outp) + (size_t)ro * DM) + lane;
            f32x4 v[16]; float ss = 0.f;
#pragma unroll
            for (int j = 0; j < 16; ++j) { const v2u a = d0[64 * j], c = d1[64 * j];
                v[j] = s4[64 * j] + (f32x4){bflo(a.x), bfhi(a.x), bflo(a.y), bfhi(a.y)} + (f32x4){bflo(c.x), bfhi(c.x), bflo(c.y), bfhi(c.y)};
                ss += (v[j].x * v[j].x + v[j].y * v[j].y) + (v[j].z * v[j].z + v[j].w * v[j].w); }
            const float rstd = 1.f / sqrtf(wave_sum(ss, lane) * (1.f / DM) + EPS);
#pragma unroll
            for (int j = 0; j < 16; ++j) { const f32x4 gg = ((const LAS f32x4*)ldsl)[lane + 64 * j]; d4[64 * j] = v[j] * rstd * gg; }
        }
        REPBAR(7);
    }
#undef IN
#undef SEAM
}

extern "C" void kernel_launch(void* const* d_in, const int* in_sizes, int n_in, void* d_out, int out_size, void* d_ws, size_t ws_size, hipStream_t stream) {
    static int grid = 0;
    if (grid == 0) {
        if (n_in != 18 || in_sizes[0] != NB * SEQ * DM || out_size != NB * SEQ * DM || ws_size < WS_END) {
            fprintf(stderr, "kernel_launch: shape/workspace mismatch: n_in %d in0 %d out %d ws %zu (need %zu)\n", n_in, n_in > 0 ? in_sizes[0] : -1, out_size, ws_size, (size_t)WS_END); grid = -1; return; }
        int dev = 0, cus = 0, per_cu = 0;
        if (hipGetDevice(&dev) != hipSuccess || hipDeviceGetAttribute(&cus, hipDeviceAttributeMultiprocessorCount, dev) != hipSuccess) { fprintf(stderr, "kernel_launch: device query failed\n"); grid = -1; return; }
        if (hipFuncSetAttribute((const void*)mk_fwd, hipFuncAttributeMaxDynamicSharedMemorySize, LDS_BYTES) != hipSuccess) { fprintf(stderr, "kernel_launch: hipFuncSetAttribute failed\n"); grid = -1; return; }
        if (hipOccupancyMaxActiveBlocksPerMultiprocessor(&per_cu, (const void*)mk_fwd, NWAVES * 64, LDS_BYTES) != hipSuccess || per_cu < 1)
            fprintf(stderr, "kernel_launch: note: occupancy query reports %d workgroups per CU\n", per_cu);
        (void)hipGetLastError();
        grid = cus;
    }
    if (grid < 0) return;
    if (hipMemsetAsync((char*)d_ws + WS_CTL, 0, CTL_ZERO_BYTES, stream) != hipSuccess) { fprintf(stderr, "kernel_launch: memset failed\n"); return; }
    Args a{};
    for (int i = 0; i < 18; ++i) a.in[i] = (const float*)d_in[i];
    a.out = (float*)d_out; a.ws = (unsigned char*)d_ws;
#if MK_PER_PHASE
    for (int ph = 0; ph < NPHASE; ++ph) { a.ph_lo = ph; a.ph_hi = ph + 1; hipLaunchKernelGGL(mk_fwd, dim3(grid), dim3(NWAVES * 64), LDS_BYTES, stream, a); }
#else
    a.ph_lo = 0; a.ph_hi = NPHASE;
    hipLaunchKernelGGL(mk_fwd, dim3(grid), dim3(NWAVES * 64), LDS_BYTES, stream, a);
#endif
    const hipError_t le = hipPeekAtLastError();
    if (le != hipSuccess) fprintf(stderr, "kernel_launch: launch failed: %s\n", hipGetErrorName(le));
}
```

```cpp
#include <hip/hip_runtime.h>
#include <hip/hip_bf16.h>
#include <cstdio>
#include <cstdint>

#ifndef MK_REP
#define MK_REP 0
#endif
#ifndef MK_AVAR
#define MK_AVAR 0
#endif
#ifndef MK_PER_PHASE
#define MK_PER_PHASE 0
#endif

__device__ __forceinline__ int hw_lane() { int l; asm volatile("v_mbcnt_lo_u32_b32 %0, -1, 0\n\tv_mbcnt_hi_u32_b32 %0, -1, %0" : "=&v"(l)); return l; }
namespace pg8 {
#define PG8_LAS __attribute__((address_space(3)))
typedef unsigned short bf16_t;
typedef short bf16x8 __attribute__((ext_vector_type(8)));
typedef float f32x4 __attribute__((ext_vector_type(4)));
typedef unsigned u32x4 __attribute__((ext_vector_type(4)));
constexpr int BM = 256, BK = 64, HALF = 128, HTB = HALF * BK * 2, STAGE_BYTES = 8 * HTB, NXCD = 8, WGM = 8;

__host__ __device__ __forceinline__ int lds_byte(int r, int c) { const int st = (r >> 4) * 2 + (c >> 5), rr = r & 15, cc = c & 31, ob = rr * 64 + cc * 2; return st * 1024 + (ob ^ (((ob >> 9) & 1) << 5)); }
__host__ __device__ __forceinline__ void stage_rc(int b, int& R, int& C) { const int st = b / 1024, sb = b % 1024, swz = sb ^ (((sb >> 9) & 1) << 5); R = (st >> 1) * 16 + swz / 64; C = (st & 1) * 32 + (swz % 64) / 2; }
__host__ __device__ __forceinline__ int perm32(int rho) { const int n = rho >> 4, i = rho & 15; return 8 * (i >> 2) + 4 * n + (i & 3); }

struct Unit { int pm, pn, ko, f8; };
struct Gemm { const bf16_t* A; const bf16_t* Bt; int lda, ldb, K; const unsigned char* A8 = nullptr; const unsigned char* B8 = nullptr; };
constexpr unsigned long long F8MASK = 0xFFF0FFULL | (0xFFULL << 36);
constexpr int F8N = 28, BFN = 52 - 28;
static_assert(__builtin_popcountll(F8MASK) == F8N, "tile set");
__host__ __device__ __forceinline__ bool f8_tile(int pn) { return (F8MASK >> pn) & 1ULL; }
__host__ __device__ __forceinline__ int f8_tile_index(int pn) { return __builtin_popcountll(F8MASK & ((1ULL << pn) - 1ULL)); }
__host__ __device__ __forceinline__ int nth_tile(int v, bool set) { unsigned long long m = set ? F8MASK : ~F8MASK; for (int i = 0; i < v; ++i) m &= m - 1ULL; return __builtin_ctzll(m); }

struct StaticOrder {
    int nM, nN, nwg, G, c;
    __host__ __device__ void init(int M, int N, int G_, int c_) { nM = M / BM; nN = N / BM; nwg = nM * nN; G = G_; c = c_; }
    __host__ __device__ bool next(int i, Unit& u) const {
        const long L = (long)i * G + c; if (L >= nwg) return false;
        int wgid = (int)L; { const int q = nwg / NXCD, r = nwg % NXCD, xcd = wgid % NXCD, off = wgid / NXCD; wgid = (xcd < r ? xcd * (q + 1) : r * (q + 1) + (xcd - r) * q) + off; }
        const int nig = WGM * nN, gid = wgid / nig, fm = gid * WGM, gsz = (nM - fm) < WGM ? (nM - fm) : WGM;
        u.pm = fm + ((wgid % nig) % gsz); u.pn = (wgid % nig) / gsz; u.ko = 0; u.f8 = 0; return true;
    }
    __device__ __forceinline__ void a_ready(const Unit&) const {}
    __device__ __forceinline__ void done(const Unit&) const {}
};
struct RowMapOrder {
    StaticOrder so; int latent_only; int ctx_ntiles; int colmap = 0;
    __device__ __forceinline__ bool next(int i, Unit& u) const {
        if (so.next(i, u)) { if (latent_only) u.pm = (u.pm >> 4) * 17 + 1 + (u.pm & 15); if (colmap) u.pn = nth_tile(u.pn, colmap == 1); return true; }
        const int L = i * so.G + so.c - so.nwg;
        if (L < 2 * ctx_ntiles) { u.pm = (L / ctx_ntiles) * 17; u.pn = colmap ? nth_tile(L % ctx_ntiles, colmap == 1) : L % ctx_ntiles; u.ko = 0; u.f8 = 0; return true; }
        return false; }
    __device__ __forceinline__ void a_ready(const Unit&) const {}
    __device__ __forceinline__ void done(const Unit&) const {}
};

struct CtxSplitOrder {
    int G, c;
    __device__ __forceinline__ bool next(int i, Unit& u) const { const int L = i * G + c; if (L >= 256) return false; const int tile = L >> 3; u.pm = (tile >> 4) * 17; u.pn = tile & 15; u.ko = (L & 7) * 512; u.f8 = 0; return true; }
    __device__ __forceinline__ void a_ready(const Unit&) const {}
    __device__ __forceinline__ void done(const Unit&) const {}
};

__device__ __forceinline__ unsigned cvt_pk_bf16(float lo, float hi) { unsigned r; asm volatile("v_cvt_pk_bf16_f32 %0, %1, %2" : "=v"(r) : "v"(lo), "v"(hi)); return r; }

struct EpiBf16 {
    static constexpr bool PERM = true, AFTER_DRAIN = false;
    bf16_t* O; int ldc;
    __device__ __forceinline__ void operator()(const f32x4 (&acc)[2][2][4][2], const Unit& u, int wr, int wc, int fr, int fq) const {
        asm volatile("" : "+v"(fr), "+v"(fq));
        const int row0 = u.pm * BM + wr * 64 + fr; const int col0 = u.pn * BM + wc * 32 + 8 * fq;
#pragma unroll
        for (int ai = 0; ai < 2; ++ai)
#pragma unroll
            for (int m = 0; m < 4; ++m) { bf16_t* rowp = O + (size_t)(row0 + ai * HALF + m * 16) * ldc + col0;
#pragma unroll
                for (int bj = 0; bj < 2; ++bj) { const f32x4 v0 = acc[ai][bj][m][0], v1 = acc[ai][bj][m][1];
                    u32x4 w; w.x = cvt_pk_bf16(v0[0], v0[1]); w.y = cvt_pk_bf16(v0[2], v0[3]); w.z = cvt_pk_bf16(v1[0], v1[1]); w.w = cvt_pk_bf16(v1[2], v1[3]);
                    *(u32x4*)(rowp + bj * HALF) = w; } }
    }
};
struct EpiGate {
    static constexpr bool PERM = true, AFTER_DRAIN = false;
    bf16_t* D; const float* mod;
    __device__ __forceinline__ void operator()(const f32x4 (&acc)[2][2][4][2], const Unit& u, int wr, int wc, int fr, int fq) const {
        const float* gate = mod + (u.pm / 17) * 12288 + 8192;
        const int row0 = u.pm * BM + wr * 64 + fr, col0 = u.pn * BM + wc * 32 + 8 * fq;
        f32x4 gv[2][2];
#pragma unroll
        for (int bj = 0; bj < 2; ++bj)
#pragma unroll
            for (int n = 0; n < 2; ++n) gv[bj][n] = *(const f32x4*)(gate + col0 + bj * HALF + 4 * n);
#pragma unroll
        for (int ai = 0; ai < 2; ++ai)
#pragma unroll
            for (int m = 0; m < 4; ++m) { bf16_t* rowp = D + (size_t)(row0 + ai * HALF + m * 16) * 4096 + col0;
#pragma unroll
                for (int bj = 0; bj < 2; ++bj) { const f32x4 v0 = acc[ai][bj][m][0] * gv[bj][0], v1 = acc[ai][bj][m][1] * gv[bj][1];
                    u32x4 w; w.x = cvt_pk_bf16(v0[0], v0[1]); w.y = cvt_pk_bf16(v0[2], v0[3]); w.z = cvt_pk_bf16(v1[0], v1[1]); w.w = cvt_pk_bf16(v1[2], v1[3]);
                    *(u32x4*)(rowp + bj * HALF) = w; } }
    }
};

struct EpiSlab {
    static constexpr bool PERM = false, AFTER_DRAIN = false;
    float* slab;
    __device__ __forceinline__ void operator()(const f32x4 (&acc)[2][2][4][2], const Unit& u, int wr, int wc, int fr, int fq) const {
        float* base = slab + ((size_t)(u.ko >> 9) * 512 + (size_t)(u.pm / 17) * 256) * 4096;
        const int lr0 = wr * 64 + fr, col0 = u.pn * BM + wc * 32 + 4 * fq;
#pragma unroll
        for (int ai = 0; ai < 2; ++ai)
#pragma unroll
            for (int m = 0; m < 4; ++m) { float* rowp = base + (size_t)(lr0 + ai * HALF + m * 16) * 4096 + col0;
#pragma unroll
                for (int bj = 0; bj < 2; ++bj)
#pragma unroll
                    for (int n = 0; n < 2; ++n) *(f32x4*)(rowp + bj * HALF + n * 16) = acc[ai][bj][m][n]; }
    }
};

typedef int v8i_t __attribute__((ext_vector_type(8)));
__device__ __forceinline__ v8i_t cat8(bf16x8 lo, bf16x8 hi) { typedef int i4_t __attribute__((ext_vector_type(4))); const i4_t a = __builtin_bit_cast(i4_t, lo), b = __builtin_bit_cast(i4_t, hi); return (v8i_t){a.x, a.y, a.z, a.w, b.x, b.y, b.z, b.w}; }
template <class Epi, class Sched, bool ALIGN_EPI = false, bool SP2 = false, bool MIXF8 = false>
__device__ __forceinline__ void gemm_phase(PG8_LAS unsigned char* lds, const Gemm g, const Sched& S, const Epi& E, int wv) {
    int tid = wv * 64 + hw_lane(); asm volatile("" : "+v"(tid));
    const int wid = __builtin_amdgcn_readfirstlane(tid >> 6), lane = tid & 63, wr = wid >> 2, wc = wid & 3, fr = lane & 15, fq = lane >> 4;
    const int K = g.K, nt = K / BK;
    unsigned voffA[2], voffB[2];
    const int pitchA = MIXF8 ? g.lda : g.lda * 2, pitchB = MIXF8 ? g.ldb : g.ldb * 2;
#pragma unroll
    for (int i = 0; i < 2; ++i) { int R, C; stage_rc(tid * 16 + i * 8192, R, C); const int Rb = Epi::PERM ? ((R & ~31) + perm32(R & 31)) : R;
        voffA[i] = (unsigned)(R * pitchA + C * 2); voffB[i] = (unsigned)(Rb * pitchB + C * 2); }
    const size_t kstep = (size_t)(BK * 2);
    const size_t hstepA = (size_t)HALF * pitchA, hstepB = (size_t)HALF * pitchB;
    const size_t tstepA = 2 * hstepA, tstepB = 2 * hstepB;
    const unsigned ldsw = (unsigned)wid * 1024u, ldsb = (unsigned)(size_t)lds;
    const int aoff = lds_byte(wr * 64 + fr, fq * 8), boff = lds_byte(wc * 32 + fr, fq * 8);
#define PG8_SA(b, h) (((b) * 2 + (h)) * HTB)
#define PG8_SB(b, h) ((4 + (b) * 2 + (h)) * HTB)
#define PG8_STAGE(bufoff, gbase, voff) do { _Pragma("unroll") for (int _i = 0; _i < 2; ++_i) \
        asm volatile("s_mov_b32 m0, %2\n\ts_nop 0\n\tglobal_load_lds_dwordx4 %0, %1" :: "v"((voff)[_i]), "s"((const char*)(gbase)), "s"((unsigned)__builtin_amdgcn_readfirstlane((int)(ldsb + (unsigned)(bufoff) + ldsw + _i * 8192u))) : "memory", "m0"); } while (0)
#define PG8_LDA(dst, b, h) do { if constexpr (MIXF8) { _Pragma("unroll") for (int m = 0; m < 4; ++m) dst##8[m] = cat8(*(const PG8_LAS bf16x8*)(lds + PG8_SA(b, h) + aoff + m * 2048), *(const PG8_LAS bf16x8*)(lds + PG8_SA(b, h) + aoff + m * 2048 + 1024)); } \
    else { _Pragma("unroll") for (int m = 0; m < 4; ++m) _Pragma("unroll") for (int k = 0; k < 2; ++k) dst[m][k] = *(const PG8_LAS bf16x8*)(lds + PG8_SA(b, h) + aoff + m * 2048 + k * 1024); } } while (0)
#define PG8_LDB(dst, b, h) do { if constexpr (MIXF8) { _Pragma("unroll") for (int n = 0; n < 2; ++n) dst##8[n] = cat8(*(const PG8_LAS bf16x8*)(lds + PG8_SB(b, h) + boff + n * 2048), *(const PG8_LAS bf16x8*)(lds + PG8_SB(b, h) + boff + n * 2048 + 1024)); } \
    else { _Pragma("unroll") for (int n = 0; n < 2; ++n) _Pragma("unroll") for (int k = 0; k < 2; ++k) dst[n][k] = *(const PG8_LAS bf16x8*)(lds + PG8_SB(b, h) + boff + n * 2048 + k * 1024); } } while (0)
#define PG8_MMA(ai, bj, At, Bt) do { __builtin_amdgcn_s_setprio(1); if constexpr (MIXF8) { _Pragma("unroll") for (int m = 0; m < 4; ++m) _Pragma("unroll") for (int n = 0; n < 2; ++n) \
        acc[ai][bj][m][n] = __builtin_amdgcn_mfma_scale_f32_16x16x128_f8f6f4(Bt##8[n], At##8[m], acc[ai][bj][m][n], 0, 0, 0, 0x75757575, 0, 0x7b7b7b7b); } \
      else { _Pragma("unroll") for (int m = 0; m < 4; ++m) _Pragma("unroll") for (int n = 0; n < 2; ++n) _Pragma("unroll") for (int k = 0; k < 2; ++k) \
        acc[ai][bj][m][n] = __builtin_amdgcn_mfma_f32_16x16x32_bf16(Bt[n][k], At[m][k], acc[ai][bj][m][n], 0, 0, 0); } __builtin_amdgcn_s_setprio(0); } while (0)
#define PG8_WAIT_V(n) asm volatile("s_waitcnt vmcnt(" #n ")" ::: "memory")
#define PG8_WAIT_L(n) asm volatile("s_waitcnt lgkmcnt(" #n ")" ::: "memory")
#define PG8_BAR __builtin_amdgcn_s_barrier()
#define PG8_SCHED __builtin_amdgcn_sched_barrier(0)
    Unit cur, nxt; int ui = 0;
    if (!S.next(0, cur)) return;
    f32x4 acc[2][2][4][2];
#pragma unroll
    for (int a = 0; a < 2; ++a)
#pragma unroll
        for (int b = 0; b < 2; ++b)
#pragma unroll
            for (int m = 0; m < 4; ++m)
#pragma unroll
                for (int n = 0; n < 2; ++n) acc[a][b][m][n] = (f32x4){0.f, 0.f, 0.f, 0.f};
    bf16x8 At[4][2], B0[2][2], B1[2][2]; v8i_t At8[4], B08[2], B18[2];
#define PG8_ABASE(u) (MIXF8 ? (const char*)g.A8 + (size_t)(u).pm * tstepA : (const char*)g.A + (size_t)(u).pm * tstepA + (size_t)(u).ko * 2)
#define PG8_BBASE(u) (MIXF8 ? (const char*)g.B8 + (size_t)f8_tile_index((u).pn) * tstepB : (const char*)g.Bt + (size_t)(u).pn * tstepB + (size_t)(u).ko * 2)
    const char* cA = PG8_ABASE(cur); const char* cB = PG8_BBASE(cur);
    const int cnt = MIXF8 ? nt / 2 : nt;
    S.a_ready(cur);
    if constexpr (SP2) {
        PG8_STAGE(PG8_SB(0, 0), cB, voffB); PG8_STAGE(PG8_SB(0, 1), cB + hstepB, voffB); PG8_STAGE(PG8_SA(0, 0), cA, voffA); PG8_STAGE(PG8_SA(0, 1), cA + hstepA, voffA);
        if (wr == 1) PG8_BAR;
        PG8_WAIT_V(2); PG8_BAR;
        PG8_STAGE(PG8_SB(1, 0), cB + kstep, voffB); PG8_STAGE(PG8_SA(1, 0), cA + kstep, voffA); PG8_STAGE(PG8_SB(1, 1), cB + hstepB + kstep, voffB);
        PG8_WAIT_V(6); PG8_BAR;
    } else {
        PG8_STAGE(PG8_SB(0, 0), cB, voffB); PG8_STAGE(PG8_SA(0, 0), cA, voffA); PG8_STAGE(PG8_SB(0, 1), cB + hstepB, voffB); PG8_STAGE(PG8_SA(0, 1), cA + hstepA, voffA);
        if (wr == 1) PG8_BAR;
        PG8_WAIT_V(4); PG8_BAR;
        PG8_STAGE(PG8_SB(1, 0), cB + kstep, voffB); PG8_STAGE(PG8_SA(1, 0), cA + kstep, voffA); PG8_STAGE(PG8_SB(1, 1), cB + hstepB + kstep, voffB);
        PG8_WAIT_V(6); PG8_BAR;
    }
    for (;;) {
        const bool has_next = S.next(ui + 1, nxt);
        const char* nA = has_next ? PG8_ABASE(nxt) : cA; const char* nB = has_next ? PG8_BBASE(nxt) : cB;
        for (int t = 0; t < cnt; t += 2) {
            const bool last = (t == cnt - 2);
            const char* a1 = cA + (size_t)(t + 1) * kstep;
            const char* a2 = last ? nA : cA + (size_t)(t + 2) * kstep; const char* b2 = last ? nB : cB + (size_t)(t + 2) * kstep;
            const char* a3 = a2 + kstep; const char* b3 = b2 + kstep;
            if (last && has_next) S.a_ready(nxt);
            if constexpr (SP2) {
            PG8_LDB(B0, 0, 0); PG8_LDB(B1, 0, 1); PG8_SCHED; PG8_LDA(At, 0, 0); PG8_STAGE(PG8_SA(1, 1), a1 + hstepA, voffA);
            PG8_WAIT_V(8); PG8_WAIT_L(0); PG8_BAR; PG8_MMA(0, 0, At, B0); PG8_MMA(0, 1, At, B1); PG8_BAR; PG8_SCHED;
            PG8_LDA(At, 0, 1); PG8_STAGE(PG8_SB(0, 0), b2, voffB); PG8_STAGE(PG8_SB(0, 1), b2 + hstepB, voffB); PG8_STAGE(PG8_SA(0, 0), a2, voffA);
            PG8_WAIT_V(8); PG8_WAIT_L(0); PG8_BAR; PG8_MMA(1, 0, At, B0); PG8_MMA(1, 1, At, B1); PG8_BAR; PG8_SCHED;
            PG8_LDB(B0, 1, 0); PG8_LDB(B1, 1, 1); PG8_SCHED; PG8_LDA(At, 1, 0); PG8_STAGE(PG8_SA(0, 1), a2 + hstepA, voffA);
            PG8_WAIT_V(8); PG8_WAIT_L(0); PG8_BAR; PG8_MMA(0, 0, At, B0); PG8_MMA(0, 1, At, B1); PG8_BAR; PG8_SCHED;
            PG8_LDA(At, 1, 1); PG8_STAGE(PG8_SB(1, 0), b3, voffB); PG8_STAGE(PG8_SB(1, 1), b3 + hstepB, voffB); PG8_STAGE(PG8_SA(1, 0), a3, voffA);
            PG8_WAIT_V(8); PG8_WAIT_L(0); PG8_BAR; PG8_MMA(1, 0, At, B0); PG8_MMA(1, 1, At, B1); PG8_BAR; PG8_SCHED;
            } else {
            PG8_LDB(B0, 0, 0); PG8_SCHED; PG8_LDA(At, 0, 0); PG8_STAGE(PG8_SA(1, 1), a1 + hstepA, voffA);
            PG8_WAIT_L(8); PG8_BAR; PG8_WAIT_L(0); PG8_MMA(0, 0, At, B0); PG8_BAR; PG8_SCHED;
            PG8_LDB(B1, 0, 1); PG8_STAGE(PG8_SB(0, 0), b2, voffB);
            PG8_BAR; PG8_WAIT_L(0); PG8_MMA(0, 1, At, B1); PG8_BAR;
            PG8_LDA(At, 0, 1); PG8_STAGE(PG8_SA(0, 0), a2, voffA);
            PG8_BAR; PG8_WAIT_L(0); PG8_MMA(1, 0, At, B0); PG8_BAR; PG8_SCHED;
            PG8_STAGE(PG8_SB(0, 1), b2 + hstepB, voffB);
            PG8_WAIT_V(6); PG8_BAR; PG8_MMA(1, 1, At, B1); PG8_BAR;
            PG8_LDB(B0, 1, 0); PG8_SCHED; PG8_LDA(At, 1, 0); PG8_STAGE(PG8_SA(0, 1), a2 + hstepA, voffA);
            PG8_WAIT_L(8); PG8_BAR; PG8_WAIT_L(0); PG8_MMA(0, 0, At, B0); PG8_BAR; PG8_SCHED;
            PG8_LDB(B1, 1, 1); PG8_STAGE(PG8_SB(1, 0), b3, voffB);
            PG8_BAR; PG8_WAIT_L(0); PG8_MMA(0, 1, At, B1); PG8_BAR;
            PG8_LDA(At, 1, 1); PG8_STAGE(PG8_SA(1, 0), a3, voffA);
            PG8_BAR; PG8_WAIT_L(0); PG8_MMA(1, 0, At, B0); PG8_BAR; PG8_SCHED;
            PG8_STAGE(PG8_SB(1, 1), b3 + hstepB, voffB);
            PG8_WAIT_V(6); PG8_BAR; PG8_MMA(1, 1, At, B1); PG8_BAR;
            }
        }
        if constexpr (ALIGN_EPI) { if (wr == 0) PG8_BAR; }
        if constexpr (!Epi::AFTER_DRAIN) { const int le = hw_lane() & 63; E(acc, cur, wr, wc, le & 15, le >> 4); S.done(cur); }
        if (!has_next) break;
#pragma unroll
        for (int a = 0; a < 2; ++a)
#pragma unroll
            for (int b = 0; b < 2; ++b)
#pragma unroll
                for (int m = 0; m < 4; ++m)
#pragma unroll
                    for (int n = 0; n < 2; ++n) acc[a][b][m][n] = (f32x4){0.f, 0.f, 0.f, 0.f};
        cur = nxt; cA = nA; cB = nB; ++ui;
        if constexpr (ALIGN_EPI) { if (wr == 1) PG8_BAR; }
    }
    PG8_WAIT_V(0);
    if constexpr (!ALIGN_EPI) { if (wr == 0) PG8_BAR; }
    PG8_BAR;
#undef PG8_ABASE
#undef PG8_BBASE
#undef PG8_SA
#undef PG8_SB
#undef PG8_STAGE
#undef PG8_LDA
#undef PG8_LDB
#undef PG8_MMA
#undef PG8_WAIT_V
#undef PG8_WAIT_L
#undef PG8_BAR
#undef PG8_SCHED
}
}

namespace att {
using bf16 = __hip_bfloat16;
constexpr int   D = 128, NW = 8, QBLK = 32, KVBLK = 64;
constexpr float SCALE = 0.088388347648318440f;
constexpr float THR = 8.f;
constexpr size_t SHM_V = KVBLK * D * 2, SHM_K = KVBLK * D * 2, SHM_ATTN = 2 * SHM_V + 2 * SHM_K + NW * 64 * 4;
using bf16x8 = __attribute__((ext_vector_type(8))) short;
using s16x4  = __attribute__((ext_vector_type(4))) short;
using f32x16 = __attribute__((ext_vector_type(16))) float;
using u32x4  = __attribute__((ext_vector_type(4))) unsigned;
#define KSWZ(row, colB) ((row) * 256 + ((colB) ^ (((row) & 7) << 4)))
#define SBAR() __builtin_amdgcn_sched_barrier(0)
__device__ __forceinline__ int crow(int r, int hi) { return (r & 3) + 8 * (r >> 2) + 4 * hi; }
__device__ __forceinline__ unsigned cvtpk(float lo, float hi) { unsigned r; asm volatile("v_cvt_pk_bf16_f32 %0, %1, %2" : "=v"(r) : "v"(lo), "v"(hi)); return r; }
__device__ __forceinline__ bf16x8 ld8(const bf16* p) { return *reinterpret_cast<const bf16x8*>(p); }

__device__ __forceinline__ void partialSM(f32x16& p0, f32x16& p1, float& m_reg, float& mn, float& alpha) {
  constexpr float C = SCALE * 1.4426950408889634f;
  float pmax = p0[0]; for (int r = 1; r < 16; ++r) pmax = fmaxf(pmax, p0[r]); for (int r = 0; r < 16; ++r) pmax = fmaxf(pmax, p1[r]);
  { auto rr = __builtin_amdgcn_permlane32_swap(__float_as_uint(pmax), __float_as_uint(pmax), false, false);
    pmax = fmaxf(__uint_as_float(rr[0]), __uint_as_float(rr[1])); }
  if (__builtin_expect(__all(pmax - m_reg <= THR / SCALE), 1)) { mn = m_reg; alpha = 1.f; }
  else { mn = fmaxf(m_reg, pmax); alpha = __builtin_amdgcn_exp2f((m_reg - mn) * C); m_reg = mn; }
  float mnC = -mn * C;
  for (int r = 0; r < 16; ++r) p0[r] = fmaf(p0[r], C, mnC); for (int r = 0; r < 16; ++r) p1[r] = fmaf(p1[r], C, mnC);
  for (int r = 0; r < 16; ++r) p0[r] = __builtin_amdgcn_exp2f(p0[r]);
}
__device__ __forceinline__ void finishSM(f32x16& p0, f32x16& p1, float alpha, float& l_reg, bf16x8& pa0, bf16x8& pa1, bf16x8& pa2, bf16x8& pa3) {
  for (int r = 0; r < 16; ++r) p1[r] = __builtin_amdgcn_exp2f(p1[r]);
  float ps = 0; for (int r = 0; r < 16; ++r) ps += p0[r]; for (int r = 0; r < 16; ++r) ps += p1[r];
  { auto rr = __builtin_amdgcn_permlane32_swap(__float_as_uint(ps), __float_as_uint(ps), false, false);
    ps = __uint_as_float(rr[0]) + __uint_as_float(rr[1]); }
  l_reg = l_reg * alpha + ps;
#define PK4(P, BASE, OUT) do { unsigned a0 = cvtpk(P[BASE + 0], P[BASE + 1]), a1 = cvtpk(P[BASE + 2], P[BASE + 3]);   \
    unsigned b0 = cvtpk(P[BASE + 4], P[BASE + 5]), b1 = cvtpk(P[BASE + 6], P[BASE + 7]);                              \
    auto r0 = __builtin_amdgcn_permlane32_swap(a0, b0, false, false); auto r1 = __builtin_amdgcn_permlane32_swap(a1, b1, false, false); \
    u32x4 w = {r0[0], r1[0], r0[1], r1[1]}; OUT = *reinterpret_cast<bf16x8*>(&w); } while (0)
  PK4(p0, 0, pa0); PK4(p0, 8, pa1); PK4(p1, 0, pa2); PK4(p1, 8, pa3);
#undef PK4
}
__device__ __forceinline__ void qkt(f32x16& p0, f32x16& p1, const bf16* Ks, const bf16x8* qr, int r32, int hi) {
  p0 = f32x16{}; p1 = f32x16{};
  for (int d0 = 0; d0 < 8; ++d0) { int cb = (d0 * 16 + hi * 8) * 2;
    bf16x8 b0 = *reinterpret_cast<const bf16x8*>((const char*)Ks + KSWZ(r32, cb));
    bf16x8 b1 = *reinterpret_cast<const bf16x8*>((const char*)Ks + KSWZ(32 + r32, cb));
    p0 = __builtin_amdgcn_mfma_f32_32x32x16_bf16(b0, qr[d0], p0, 0, 0, 0);
    p1 = __builtin_amdgcn_mfma_f32_32x32x16_bf16(b1, qr[d0], p1, 0, 0, 0); }
}
__device__ __forceinline__ int v_st(int k, int c) { const int kk = (k & ~0xC) | ((k & 4) << 1) | ((k & 8) >> 1); return ((kk >> 3) * 4 + (c >> 5)) * 512 + ((kk & 7) * 32 + (c & 31)) * 2; }
__device__ __forceinline__ int v_rd_base(int lane) { return ((lane & 3) << 3) | (((lane >> 2) & 3) << 6) | (((lane >> 4) & 1) << 5) | (((lane >> 5) & 1) << 8); }
constexpr int v_rd_off(int d0, int ks, int half) { return d0 * 512 + ks * 4096 + half * 2048; }
template <int OFF> __device__ __forceinline__ s16x4 tr_read(int vb) {
  s16x4 r; asm volatile("ds_read_b64_tr_b16 %0, %1 offset:%2" : "=&v"(r) : "v"(vb), "i"(OFF) : "memory"); return r;
}
template <int D0> __device__ __forceinline__ void pv_one(f32x16& od, int vb, bf16x8 pa0, bf16x8 pa1, bf16x8 pa2, bf16x8 pa3) {
  const s16x4 l0 = tr_read<v_rd_off(D0, 0, 0)>(vb), h0 = tr_read<v_rd_off(D0, 0, 1)>(vb), l1 = tr_read<v_rd_off(D0, 1, 0)>(vb), h1 = tr_read<v_rd_off(D0, 1, 1)>(vb);
  const s16x4 l2 = tr_read<v_rd_off(D0, 2, 0)>(vb), h2 = tr_read<v_rd_off(D0, 2, 1)>(vb), l3 = tr_read<v_rd_off(D0, 3, 0)>(vb), h3 = tr_read<v_rd_off(D0, 3, 1)>(vb);
  asm volatile("s_waitcnt lgkmcnt(0)" ::: "memory"); SBAR();
#define PK(L, H) (bf16x8){L[0], L[1], L[2], L[3], H[0], H[1], H[2], H[3]}
  od = __builtin_amdgcn_mfma_f32_32x32x16_bf16(pa0, PK(l0, h0), od, 0, 0, 0);
  od = __builtin_amdgcn_mfma_f32_32x32x16_bf16(pa1, PK(l1, h1), od, 0, 0, 0);
  od = __builtin_amdgcn_mfma_f32_32x32x16_bf16(pa2, PK(l2, h2), od, 0, 0, 0);
  od = __builtin_amdgcn_mfma_f32_32x32x16_bf16(pa3, PK(l3, h3), od, 0, 0, 0);
#undef PK
}
__device__ __forceinline__ void pv_d0(f32x16* o, int vb, bf16x8 pa0, bf16x8 pa1, bf16x8 pa2, bf16x8 pa3) {
  pv_one<0>(o[0], vb, pa0, pa1, pa2, pa3); pv_one<1>(o[1], vb, pa0, pa1, pa2, pa3); pv_one<2>(o[2], vb, pa0, pa1, pa2, pa3); pv_one<3>(o[3], vb, pa0, pa1, pa2, pa3);
}

__device__ __forceinline__ float shx(float v, int mask, int lane) { return __int_as_float(__builtin_amdgcn_ds_bpermute((lane ^ mask) << 2, __float_as_int(v))); }
typedef int v8i32 __attribute__((ext_vector_type(8)));
constexpr float QS8 = 0.088388347648318440f * 1.4426950408889634f * 128.f;
template <bool F8OUT = false>
__device__ __forceinline__ void q_prep(bf16x8 (&qr)[8], const float* __restrict__ gn, const float* __restrict__ rope, int t, int hi, int lane, v8i32* q8 = nullptr) {
  float x[8][8];
#pragma unroll
  for (int d0 = 0; d0 < 8; ++d0) { const u32x4 w = *reinterpret_cast<const u32x4*>(&qr[d0]);
    x[d0][0] = __uint_as_float(w.x << 16); x[d0][1] = __uint_as_float(w.x & 0xffff0000u); x[d0][2] = __uint_as_float(w.y << 16); x[d0][3] = __uint_as_float(w.y & 0xffff0000u);
    x[d0][4] = __uint_as_float(w.z << 16); x[d0][5] = __uint_as_float(w.z & 0xffff0000u); x[d0][6] = __uint_as_float(w.w << 16); x[d0][7] = __uint_as_float(w.w & 0xffff0000u); }
  if (gn) {
    float ss = 0.f;
#pragma unroll
    for (int d0 = 0; d0 < 8; ++d0)
#pragma unroll
      for (int i = 0; i < 8; ++i) ss += x[d0][i] * x[d0][i];
    ss += shx(ss, 32, lane);
    const float rstd = 1.f / sqrtf(ss * (1.f / 128.f) + 1e-6f);
#pragma unroll
    for (int d0 = 0; d0 < 8; ++d0) { const float4 g0 = *(const float4*)(gn + d0 * 16 + hi * 8), g1 = *(const float4*)(gn + d0 * 16 + hi * 8 + 4);
      x[d0][0] *= rstd * g0.x; x[d0][1] *= rstd * g0.y; x[d0][2] *= rstd * g0.z; x[d0][3] *= rstd * g0.w; x[d0][4] *= rstd * g1.x; x[d0][5] *= rstd * g1.y; x[d0][6] *= rstd * g1.z; x[d0][7] *= rstd * g1.w; }
  }
  if (rope) {
#pragma unroll
    for (int hf = 0; hf < 2; ++hf) { const int pos = hf ? (t & 63) : (t >> 6);
#pragma unroll
      for (int q1 = 0; q1 < 2; ++q1) { const int jx = q1 * 16 + hi * 8;
        const float4 c0 = *(const float4*)(rope + pos * 32 + jx), c1 = *(const float4*)(rope + pos * 32 + jx + 4), s0 = *(const float4*)(rope + 2048 + pos * 32 + jx), s1 = *(const float4*)(rope + 2048 + pos * 32 + jx + 4);
        const float cs[8] = {c0.x, c0.y, c0.z, c0.w, c1.x, c1.y, c1.z, c1.w}, sn[8] = {s0.x, s0.y, s0.z, s0.w, s1.x, s1.y, s1.z, s1.w};
        const int da = hf * 4 + q1, db = da + 2;
#pragma unroll
        for (int i = 0; i < 8; ++i) { const float a = x[da][i], b = x[db][i]; x[da][i] = a * cs[i] - b * sn[i]; x[db][i] = b * cs[i] + a * sn[i]; } } }
  }
#pragma unroll
  for (int d0 = 0; d0 < 8; ++d0) { u32x4 w = {cvtpk(x[d0][0], x[d0][1]), cvtpk(x[d0][2], x[d0][3]), cvtpk(x[d0][4], x[d0][5]), cvtpk(x[d0][6], x[d0][7])}; qr[d0] = *reinterpret_cast<bf16x8*>(&w); }
  if constexpr (F8OUT) {
#pragma unroll
    for (int ds = 0; ds < 2; ++ds)
#pragma unroll
      for (int w = 0; w < 8; ++w) { const int d0 = ds * 4 + (w >> 1), i = (w & 1) * 4; unsigned r = 0u;
        r = __builtin_amdgcn_cvt_pk_fp8_f32(x[d0][i] * QS8, x[d0][i + 1] * QS8, r, false); r = __builtin_amdgcn_cvt_pk_fp8_f32(x[d0][i + 2] * QS8, x[d0][i + 3] * QS8, r, true); q8[ds][w] = (int)r; }
  }
}

typedef __attribute__((address_space(3))) unsigned char lds_u8;
__device__ __forceinline__ void glds16(const void* gsrc, unsigned lds_dst) { unsigned keep;
  asm volatile("s_mov_b32 %0, m0\n\ts_mov_b32 m0, %2\n\ts_nop 0\n\tglobal_load_lds_dwordx4 %1, off\n\ts_mov_b32 m0, %0" : "=&s"(keep) : "v"(gsrc), "s"(lds_dst) : "memory"); }
__device__ __forceinline__ void qkt_l(f32x16& p0, f32x16& p1, const lds_u8* Ks, const bf16x8* qr, int r32, int hi) {
  p0 = f32x16{}; p1 = f32x16{};
#pragma unroll
  for (int d0 = 0; d0 < 8; ++d0) { const int cb = (d0 * 16 + hi * 8) * 2;
    const bf16x8 b0 = *(const __attribute__((address_space(3))) bf16x8*)(Ks + KSWZ(r32, cb));
    const bf16x8 b1 = *(const __attribute__((address_space(3))) bf16x8*)(Ks + KSWZ(32 + r32, cb));
    p0 = __builtin_amdgcn_mfma_f32_32x32x16_bf16(b0, qr[d0], p0, 0, 0, 0);
    p1 = __builtin_amdgcn_mfma_f32_32x32x16_bf16(b1, qr[d0], p1, 0, 0, 0); }
}
template <int VW> constexpr int v_rd_off2(int d0, int ks, int half) { return d0 * 512 + ks * (4096 * VW) + half * (2048 * VW); }
template <int VW, int D0> __device__ __forceinline__ void pv_one2(f32x16& od, int vb, bf16x8 pa0, bf16x8 pa1, bf16x8 pa2, bf16x8 pa3) {
  const s16x4 l0 = tr_read<v_rd_off2<VW>(D0, 0, 0)>(vb), h0 = tr_read<v_rd_off2<VW>(D0, 0, 1)>(vb), l1 = tr_read<v_rd_off2<VW>(D0, 1, 0)>(vb), h1 = tr_read<v_rd_off2<VW>(D0, 1, 1)>(vb);
  const s16x4 l2 = tr_read<v_rd_off2<VW>(D0, 2, 0)>(vb), h2 = tr_read<v_rd_off2<VW>(D0, 2, 1)>(vb), l3 = tr_read<v_rd_off2<VW>(D0, 3, 0)>(vb), h3 = tr_read<v_rd_off2<VW>(D0, 3, 1)>(vb);
  asm volatile("s_waitcnt lgkmcnt(0)" ::: "memory"); SBAR();
#define PK(L, H) (bf16x8){L[0], L[1], L[2], L[3], H[0], H[1], H[2], H[3]}
  od = __builtin_amdgcn_mfma_f32_32x32x16_bf16(pa0, PK(l0, h0), od, 0, 0, 0);
  od = __builtin_amdgcn_mfma_f32_32x32x16_bf16(pa1, PK(l1, h1), od, 0, 0, 0);
  od = __builtin_amdgcn_mfma_f32_32x32x16_bf16(pa2, PK(l2, h2), od, 0, 0, 0);
  od = __builtin_amdgcn_mfma_f32_32x32x16_bf16(pa3, PK(l3, h3), od, 0, 0, 0);
#undef PK
}
template <int VW> __device__ __forceinline__ void pv_all2(f32x16* o, int vb, bf16x8 pa0, bf16x8 pa1, bf16x8 pa2, bf16x8 pa3) {
  pv_one2<VW, 0>(o[0], vb, pa0, pa1, pa2, pa3); pv_one2<VW, 1>(o[1], vb, pa0, pa1, pa2, pa3); pv_one2<VW, 2>(o[2], vb, pa0, pa1, pa2, pa3); pv_one2<VW, 3>(o[3], vb, pa0, pa1, pa2, pa3);
  if constexpr (VW == 2) { pv_one2<VW, 4>(o[4], vb, pa0, pa1, pa2, pa3); pv_one2<VW, 5>(o[5], vb, pa0, pa1, pa2, pa3); pv_one2<VW, 6>(o[6], vb, pa0, pa1, pa2, pa3); pv_one2<VW, 7>(o[7], vb, pa0, pa1, pa2, pa3); }
}
template <int VW> constexpr int dma_slot_bytes() { return 16384 + 16384 * VW; }
template <int VW> constexpr int dma_lds_bytes() { return 2 * dma_slot_bytes<VW>() + NW * 64 * 4; }
template <int VW, int LDQ, int LDK, int LDV, int LDO, int LDZ, bool GATED, int VAR = 0>
__device__ __forceinline__ void attn_dma_body(const bf16* __restrict__ Qb, const bf16* __restrict__ Kh, const bf16* __restrict__ Vh, unsigned short* __restrict__ Ob, const unsigned short* __restrict__ Zb, int seq, lds_u8* lds,
                                              const float* __restrict__ qgain, const float* __restrict__ qrope, int qt0, int wv) {
  constexpr int SLOT = dma_slot_bytes<VW>(), NVI = 2 * VW, NOPS = 2 + NVI;
  int tid = wv * 64 + hw_lane(); asm volatile("" : "+v"(tid));
  const int wid = __builtin_amdgcn_readfirstlane(tid >> 6), lane = tid & 63, r32 = lane & 31, hi = lane >> 5;
  const unsigned lbase = (unsigned)(size_t)lds;
  __attribute__((address_space(3))) float* ws = (__attribute__((address_space(3))) float*)(lds + 2 * SLOT) + wid * 64;
  __attribute__((address_space(3))) float* li_l = ws; __attribute__((address_space(3))) float* al_l = ws + 32;
  float m_reg = -1e30f, l_reg = 0; f32x16 o[4 * VW]; bf16x8 qr[8];
#pragma unroll
  for (int d = 0; d < 4 * VW; ++d) o[d] = f32x16{};
  unsigned koff[2], voff[NVI];
#pragma unroll
  for (int i = 0; i < 2; ++i) { const int ch = i * 512 + tid, row = ch >> 4, sc = ch & 15, c = sc ^ (row & 7); koff[i] = (unsigned)(row * LDK + c * 8); }
#pragma unroll
  for (int i = 0; i < NVI; ++i) { const int ch = i * 512 + tid, st = ch >> 5, kk7 = (ch >> 2) & 7, c8 = ch & 3, kg = st / (4 * VW), cblk = st % (4 * VW), kk = kg * 8 + kk7;
    const int k = (kk & ~0xC) | ((kk & 4) << 1) | ((kk & 8) >> 1); voff[i] = (unsigned)(k * LDV + cblk * 32 + c8 * 8); }
  const unsigned ldsw = lbase + (unsigned)wid * 1024u;
#define ISSUE(slot, k0) do { _Pragma("unroll") for (int _i = 0; _i < 2; ++_i) glds16(Kh + (size_t)(k0) * LDK + koff[_i], (unsigned)__builtin_amdgcn_readfirstlane(ldsw + (slot) * SLOT + _i * 8192)); \
    _Pragma("unroll") for (int _i = 0; _i < NVI; ++_i) glds16(Vh + (size_t)(k0) * LDV + voff[_i], (unsigned)__builtin_amdgcn_readfirstlane(ldsw + (slot) * SLOT + 16384 + _i * 8192)); } while (0)
#define WAITBAR(N) asm volatile("s_waitcnt vmcnt(" #N ") lgkmcnt(0)\n\ts_barrier" ::: "memory")
#define LBAR() asm volatile("s_waitcnt lgkmcnt(0)\n\ts_barrier" ::: "memory")
#define RESC(a) do { if (__any((a) < 1.f)) { if (hi == 0) al_l[r32] = (a); asm volatile("s_waitcnt lgkmcnt(0)" ::: "memory"); \
    _Pragma("unroll") for (int d = 0; d < 4 * VW; ++d) _Pragma("unroll") for (int r = 0; r < 16; ++r) o[d][r] *= al_l[crow(r, hi)]; } } while (0)
#define TILE(slot) do { if constexpr (VAR != 4) qkt_l(p0, p1, lds + (slot) * SLOT, qr, r32, hi); else { asm volatile("" : "+v"(p0), "+v"(p1)); } \
    if constexpr (VAR != 1) { partialSM(p0, p1, m_reg, mn, al); RESC(al); finishSM(p0, p1, al, l_reg, pa0, pa1, pa2, pa3); } \
    else { u32x4 w0 = {cvtpk(p0[0], p0[1]), cvtpk(p0[2], p0[3]), cvtpk(p0[4], p0[5]), cvtpk(p0[6], p0[7])}, w1 = {cvtpk(p0[8], p0[9]), cvtpk(p0[10], p0[11]), cvtpk(p0[12], p0[13]), cvtpk(p0[14], p0[15])}, \
           w2 = {cvtpk(p1[0], p1[1]), cvtpk(p1[2], p1[3]), cvtpk(p1[4], p1[5]), cvtpk(p1[6], p1[7])}, w3 = {cvtpk(p1[8], p1[9]), cvtpk(p1[10], p1[11]), cvtpk(p1[12], p1[13]), cvtpk(p1[14], p1[15])}; \
           pa0 = *reinterpret_cast<bf16x8*>(&w0); pa1 = *reinterpret_cast<bf16x8*>(&w1); pa2 = *reinterpret_cast<bf16x8*>(&w2); pa3 = *reinterpret_cast<bf16x8*>(&w3); l_reg = 1.f; } \
    SBAR(); \
    if constexpr (VAR != 2) pv_all2<VW>(o, vb0 + (slot) * SLOT, pa0, pa1, pa2, pa3); else { asm volatile("" :: "v"(pa0), "v"(pa1), "v"(pa2), "v"(pa3)); } } while (0)
  const int NT = seq / KVBLK;
  ISSUE(0, 0); ISSUE(1, KVBLK);
  const bf16* Qw = Qb + (long)(wid * QBLK + r32) * LDQ + hi * 8;
#pragma unroll
  for (int d0 = 0; d0 < 8; ++d0) qr[d0] = ld8(Qw + d0 * 16);
  q_prep(qr, qgain, qrope, qt0 + wid * QBLK + r32, hi, lane);
#pragma unroll
  for (int d0 = 0; d0 < 8; ++d0) asm volatile("" :: "v"(qr[d0]));
  const int vb0 = (int)lbase + 16384 + v_rd_base(lane);
  f32x16 p0 = {}, p1 = {}; float mn, al; bf16x8 pa0, pa1, pa2, pa3;
  for (int j = 0; j < NT; j += 2) {
    if constexpr (NOPS == 4) WAITBAR(4); else WAITBAR(6);
    TILE(0);
    LBAR();
    if (j + 2 < NT) { if constexpr (VAR != 3) ISSUE(0, (j + 2) * KVBLK); if constexpr (NOPS == 4) WAITBAR(4); else WAITBAR(6); } else WAITBAR(0);
    TILE(1);
    LBAR();
    if constexpr (VAR != 3) { if (j + 3 < NT) ISSUE(1, (j + 3) * KVBLK); }
  }
  if (hi == 0) li_l[r32] = l_reg; asm volatile("s_waitcnt lgkmcnt(0)" ::: "memory");
  float rli[16];
#pragma unroll
  for (int r = 0; r < 16; ++r) rli[r] = __builtin_amdgcn_rcpf(li_l[crow(r, hi)]);
  const bool odd = (r32 & 1) != 0; const int cpair = r32 & ~1;
  unsigned short* Ow = Ob + (long)(wid * QBLK) * LDO; const unsigned short* Zw = Zb + (long)(wid * QBLK) * LDZ;
#pragma unroll
  for (int r = 0; r < 16; r += 2) { const int orow = crow(odd ? r + 1 : r, hi);
#pragma unroll
    for (int d0 = 0; d0 < 4 * VW; ++d0) { const float a = o[d0][r] * rli[r], b = o[d0][r + 1] * rli[r + 1];
      const float recv = shx(odd ? a : b, 1, lane);
      float lo = odd ? recv : a, hi2 = odd ? b : recv;
      const long off = (long)orow * LDO + d0 * 32 + cpair;
      if constexpr (GATED) { const unsigned z = *(const unsigned*)(Zw + (long)orow * LDZ + d0 * 32 + cpair); const float z0 = __uint_as_float(z << 16), z1 = __uint_as_float(z & 0xffff0000u);
        lo *= z0 / (1.f + __expf(-z0)); hi2 *= z1 / (1.f + __expf(-z1)); }
      *(unsigned*)(Ow + off) = cvtpk(lo, hi2); } }
#undef ISSUE
#undef WAITBAR
#undef LBAR
#undef RESC
#undef TILE
}
template <int VW> constexpr int f8_slot_bytes() { return 8192 + 8192 * VW; }
template <int VW> constexpr int f8_lds_bytes() { return 2 * f8_slot_bytes<VW>() + NW * 64 * 4 + 2048; }
template <int VW, int LDQ, int LDO, int LDZ, bool GATED>
__device__ __forceinline__ void attn_fp8_body(const bf16* __restrict__ Qb, const unsigned char* __restrict__ K8, const unsigned char* __restrict__ V8, unsigned short* __restrict__ Ob,
                                              const unsigned short* __restrict__ Zb, int seq, lds_u8* lds, const float* __restrict__ qgain, const float* __restrict__ qrope, int qt0, int wv) {
  constexpr int SLOT = f8_slot_bytes<VW>();
  constexpr float THR8 = 4.f;
  constexpr float THRL = 2.f + THR8 * 1.4426950408889634f;
  int tid = wv * 64 + hw_lane(); asm volatile("" : "+v"(tid));
  const int wid = __builtin_amdgcn_readfirstlane(tid >> 6), lane = tid & 63, r32 = lane & 31, hi = lane >> 5;
  const unsigned lbase = (unsigned)(size_t)lds;
  __attribute__((address_space(3))) float* ws = (__attribute__((address_space(3))) float*)(lds + 2 * SLOT) + wid * 64;
  __attribute__((address_space(3))) float* li_l = ws; __attribute__((address_space(3))) float* al_l = ws + 32;
  float l_reg = 0; f32x16 o[4 * VW]; bf16x8 qr[8]; v8i32 q8[2];
  const unsigned ksrc = (unsigned)((tid >> 3) * 128 + (((tid & 7) ^ (((tid >> 3) >> 1) & 7)) << 4));
  const unsigned vsrc = (unsigned)((tid >> 2) * 64 + (((tid & 3) ^ (((tid >> 2) >> 2) & 3)) << 4));
  const unsigned ldsw = lbase + (unsigned)wid * 1024u;
#define ISSUE(slot, j) do { glds16(K8 + (size_t)(j) * 8192 + ksrc, (unsigned)__builtin_amdgcn_readfirstlane(ldsw + (slot) * SLOT)); \
    _Pragma("unroll") for (int _i = 0; _i < VW; ++_i) glds16(V8 + (size_t)(j) * (8192 * VW) + _i * 8192 + vsrc, (unsigned)__builtin_amdgcn_readfirstlane(ldsw + (slot) * SLOT + 8192 + _i * 8192)); } while (0)
#define WAITBAR(N) asm volatile("s_waitcnt vmcnt(" #N ") lgkmcnt(0)\n\ts_barrier" ::: "memory")
#define LBAR() asm volatile("s_waitcnt lgkmcnt(0)\n\ts_barrier" ::: "memory")
#define RESC(a) do { if (__any((a) < 1.f)) { if (hi == 0) al_l[r32] = (a); asm volatile("s_waitcnt lgkmcnt(0)" ::: "memory"); \
    _Pragma("unroll") for (int d = 0; d < 4 * VW; ++d) _Pragma("unroll") for (int r = 0; r < 16; ++r) o[d][r] *= al_l[crow(r, hi)]; \
    { _Pragma("unroll") for (int r = 0; r < 16; ++r) ls[r] *= al_l[crow(r, hi)]; } } } while (0)
  typedef __attribute__((address_space(3))) u32x4 lds_u32x4;
  const int fk = (r32 >> 1) & 7, gv = (r32 >> 2) & 3;
  const lds_u8* kA00 = lds + r32 * 128 + (((0 + hi * 2 + 0) ^ fk) << 4); const lds_u8* kA01 = lds + r32 * 128 + (((0 + hi * 2 + 1) ^ fk) << 4);
  const lds_u8* kA10 = lds + r32 * 128 + (((4 + hi * 2 + 0) ^ fk) << 4); const lds_u8* kA11 = lds + r32 * 128 + (((4 + hi * 2 + 1) ^ fk) << 4);
  const lds_u8* vA0 = lds + r32 * 64 + (((hi * 2 + 0) ^ gv) << 4); const lds_u8* vA1 = lds + r32 * 64 + (((hi * 2 + 1) ^ gv) << 4);
#define KFRAG(dst, slot, blk, ds) do { const u32x4 _a = *(const lds_u32x4*)(((ds) ? kA10 : kA00) + (slot) * SLOT + (blk) * 4096), _b = *(const lds_u32x4*)(((ds) ? kA11 : kA01) + (slot) * SLOT + (blk) * 4096); \
    dst = (v8i32){(int)_a.x, (int)_a.y, (int)_a.z, (int)_a.w, (int)_b.x, (int)_b.y, (int)_b.z, (int)_b.w}; } while (0)
#define VFRAG(dst, slot, cb) do { const u32x4 _a = *(const lds_u32x4*)(vA0 + (slot) * SLOT + 8192 + (cb) * 2048), _b = *(const lds_u32x4*)(vA1 + (slot) * SLOT + 8192 + (cb) * 2048); \
    dst = (v8i32){(int)_a.x, (int)_a.y, (int)_a.z, (int)_a.w, (int)_b.x, (int)_b.y, (int)_b.z, (int)_b.w}; } while (0)
#define MM8(A, B, C) __builtin_amdgcn_mfma_scale_f32_32x32x64_f8f6f4(A, B, C, 0, 0, 0, 0x7f7f7f7f, 0, 0x7f7f7f7f)
#define MMQ(A, B, C) __builtin_amdgcn_mfma_scale_f32_32x32x64_f8f6f4(A, B, C, 0, 0, 0, 0x7f7f7f7f, 0, 0x74747474)
  const unsigned kb00 = (unsigned)(size_t)kA00, kb01 = (unsigned)(size_t)kA01, kb10 = (unsigned)(size_t)kA10, kb11 = (unsigned)(size_t)kA11, vb0_ = (unsigned)(size_t)vA0, vb1_ = (unsigned)(size_t)vA1;
#define DSR(dst, base, off) asm volatile("ds_read_b128 %0, %1 offset:%2" : "=&v"(dst) : "v"(base), "i"(off) : "memory")
#define LW_(N, A, B) do { asm volatile("s_waitcnt lgkmcnt(" #N ")" : "+v"(A), "+v"(B) :: "memory"); SBAR(); } while (0)
#define F8(A, B) ((v8i32){(int)A.x, (int)A.y, (int)A.z, (int)A.w, (int)B.x, (int)B.y, (int)B.z, (int)B.w})
#define QK2(slot) do { u32x4 a0, b0, a1, b1; \
    DSR(a0, kb00, (slot) * SLOT); DSR(b0, kb01, (slot) * SLOT); DSR(a1, kb00, (slot) * SLOT + 4096); DSR(b1, kb01, (slot) * SLOT + 4096); \
    LW_(2, a0, b0); p0 = MMQ(F8(a0, b0), q8[0], cin); asm volatile("" : "+v"(p0)); LW_(0, a1, b1); p1 = MMQ(F8(a1, b1), q8[0], cin); asm volatile("" : "+v"(p1)); SBAR(); \
    DSR(a0, kb10, (slot) * SLOT); DSR(b0, kb11, (slot) * SLOT); DSR(a1, kb10, (slot) * SLOT + 4096); DSR(b1, kb11, (slot) * SLOT + 4096); \
    LW_(2, a0, b0); p0 = MMQ(F8(a0, b0), q8[1], p0); asm volatile("" : "+v"(p0)); LW_(0, a1, b1); p1 = MMQ(F8(a1, b1), q8[1], p1); asm volatile("" : "+v"(p1)); SBAR(); } while (0)
#define VRD(a, b, slot, cb) do { DSR(a, vb0_, (slot) * SLOT + 8192 + (cb) * 2048); DSR(b, vb1_, (slot) * SLOT + 8192 + (cb) * 2048); } while (0)
#define PIN(x) asm volatile("" : "+v"(x))
#define PV2(slot) do { u32x4 xa, xb, ya, yb; VRD(xa, xb, slot, 0); \
    VRD(ya, yb, slot, 1); LW_(2, xa, xb); o[0] = MM8(pf, F8(xa, xb), o[0]); PIN(o[0]); VRD(xa, xb, slot, 2); LW_(2, ya, yb); o[1] = MM8(pf, F8(ya, yb), o[1]); PIN(o[1]); \
    VRD(ya, yb, slot, 3); LW_(2, xa, xb); o[2] = MM8(pf, F8(xa, xb), o[2]); PIN(o[2]); VRD(xa, xb, slot, 4); LW_(2, ya, yb); o[3] = MM8(pf, F8(ya, yb), o[3]); PIN(o[3]); \
    VRD(ya, yb, slot, 5); LW_(2, xa, xb); o[4] = MM8(pf, F8(xa, xb), o[4]); PIN(o[4]); VRD(xa, xb, slot, 6); LW_(2, ya, yb); o[5] = MM8(pf, F8(ya, yb), o[5]); PIN(o[5]); \
    VRD(ya, yb, slot, 7); LW_(2, xa, xb); o[6] = MM8(pf, F8(xa, xb), o[6]); PIN(o[6]); DSR(xa, onesb, 0); DSR(xb, onesb, 1024); LW_(2, ya, yb); o[7] = MM8(pf, F8(ya, yb), o[7]); PIN(o[7]); \
    LW_(0, xa, xb); ls = MM8(pf, F8(xa, xb), ls); PIN(ls); SBAR(); } while (0)
#define TILE(slot, first) do { \
      \
    if constexpr (VW == 1) { v8i32 ka, kb, kc, kd; KFRAG(ka, slot, 0, 0); KFRAG(kb, slot, 1, 0); KFRAG(kc, slot, 0, 1); KFRAG(kd, slot, 1, 1); \
      p0 = MMQ(ka, q8[0], cin); p1 = MMQ(kb, q8[0], cin); p0 = MMQ(kc, q8[1], p0); p1 = MMQ(kd, q8[1], p1); } \
    else { QK2(slot); } \
      \
    { float pmax = p0[0]; _Pragma("unroll") for (int r = 1; r < 16; ++r) pmax = fmaxf(pmax, p0[r]); _Pragma("unroll") for (int r = 0; r < 16; ++r) pmax = fmaxf(pmax, p1[r]); \
      { auto rr = __builtin_amdgcn_permlane32_swap(__float_as_uint(pmax), __float_as_uint(pmax), false, false); pmax = fmaxf(__uint_as_float(rr[0]), __uint_as_float(rr[1])); } \
      if (__builtin_expect(!(first) && __all(pmax <= THRL), 1)) { al = 1.f; } \
      else { const float dm = (first) ? pmax - 2.f : fmaxf(pmax - 2.f, 0.f); al = (first) ? 1.f : __builtin_amdgcn_exp2f(-dm); \
        _Pragma("unroll") for (int r = 0; r < 16; ++r) { p0[r] -= dm; p1[r] -= dm; cin[r] -= dm; } } } \
      \
    v8i32 pf; { float ps = 0.f; \
      _Pragma("unroll") for (int w = 0; w < 4; ++w) { const float e0 = __builtin_amdgcn_exp2f(p0[4 * w]), e1 = __builtin_amdgcn_exp2f(p0[4 * w + 1]), e2 = __builtin_amdgcn_exp2f(p0[4 * w + 2]), e3 = __builtin_amdgcn_exp2f(p0[4 * w + 3]); \
        unsigned r_ = 0u; r_ = __builtin_amdgcn_cvt_pk_fp8_f32(e0, e1, r_, false); r_ = __builtin_amdgcn_cvt_pk_fp8_f32(e2, e3, r_, true); asm volatile("" : "+v"(r_)); pf[w] = (int)r_; SBAR(); } \
      _Pragma("unroll") for (int w = 0; w < 4; ++w) { const float e0 = __builtin_amdgcn_exp2f(p1[4 * w]), e1 = __builtin_amdgcn_exp2f(p1[4 * w + 1]), e2 = __builtin_amdgcn_exp2f(p1[4 * w + 2]), e3 = __builtin_amdgcn_exp2f(p1[4 * w + 3]); \
        unsigned r_ = 0u; r_ = __builtin_amdgcn_cvt_pk_fp8_f32(e0, e1, r_, false); r_ = __builtin_amdgcn_cvt_pk_fp8_f32(e2, e3, r_, true); asm volatile("" : "+v"(r_)); pf[4 + w] = (int)r_; SBAR(); } \
      } \
    SBAR(); RESC(al); SBAR();     \
    if constexpr (VW == 1) { _Pragma("unroll") for (int cb = 0; cb < 4; cb += 2) { v8i32 va, vb; VFRAG(va, slot, cb); VFRAG(vb, slot, cb + 1); o[cb] = MM8(pf, va, o[cb]); o[cb + 1] = MM8(pf, vb, o[cb + 1]); } \
      ls = MM8(pf, ones8, ls); }     \
    else { PV2(slot); } } while (0)
  const int NT = seq / KVBLK;
  ISSUE(0, 0); ISSUE(1, 1);
  const bf16* Qw = Qb + (long)(wid * QBLK + r32) * LDQ + hi * 8;
#pragma unroll
  for (int d0 = 0; d0 < 8; ++d0) qr[d0] = ld8(Qw + d0 * 16);
  q_prep<true>(qr, qgain, qrope, qt0 + wid * QBLK + r32, hi, lane, q8);
  asm volatile("" :: "v"(q8[0]), "v"(q8[1]));
#pragma unroll
  for (int d = 0; d < 4 * VW; ++d) o[d] = f32x16{};
  f32x16 p0, p1, cin, ls = f32x16{}; float al; v8i32 ones8;
  if constexpr (VW == 1) { int one = 0x38383838; asm volatile("" : "+v"(one)); _Pragma("unroll") for (int w = 0; w < 8; ++w) ones8[w] = one; }
  else { ((__attribute__((address_space(3))) unsigned*)(lds + 2 * SLOT + NW * 256))[tid] = 0x38383838u; }
  const unsigned onesb = lbase + 2 * SLOT + NW * 256 + (unsigned)lane * 16u;
#pragma unroll
  for (int r = 0; r < 16; ++r) { float two = 2.f; asm volatile("" : "+v"(two)); cin[r] = two; }
  if (wid >= 4) __builtin_amdgcn_s_setprio(1);
  for (int j = 0; j + 2 < NT; j += 2) {
    if constexpr (VW == 1) WAITBAR(2); else WAITBAR(3);
    TILE(0, j == 0);
    LBAR();
    ISSUE(0, j + 2); if constexpr (VW == 1) WAITBAR(2); else WAITBAR(3);
    TILE(1, false);
    LBAR();
    ISSUE(1, j + 3);
  }
  if constexpr (VW == 1) WAITBAR(2); else WAITBAR(3);
  TILE(0, NT == 2);
  WAITBAR(0);
  const bool odd = (r32 & 1) != 0; const int cpair = r32 & ~1;
  unsigned short* Ow = Ob + (long)(wid * QBLK) * LDO; const unsigned short* Zw = Zb + (long)(wid * QBLK) * LDZ;
  unsigned zr[GATED ? 8 : 1][GATED ? 4 * VW : 1];
  if constexpr (GATED) {
#pragma unroll
    for (int r = 0; r < 8; ++r) { const int orow = crow(odd ? 2 * r + 1 : 2 * r, hi);
#pragma unroll
      for (int d0 = 0; d0 < 4 * VW; ++d0) zr[r][d0] = *(const unsigned*)(Zw + (long)orow * LDZ + d0 * 32 + cpair); }
  }
  TILE(1, false);
  __builtin_amdgcn_s_setprio(0);
  float rli[16];
  if constexpr (true) {
#pragma unroll
    for (int r = 0; r < 16; ++r) rli[r] = 0.0625f * __builtin_amdgcn_rcpf(ls[r]);
  } else {
    if (hi == 0) li_l[r32] = l_reg; asm volatile("s_waitcnt lgkmcnt(0)" ::: "memory");
#pragma unroll
    for (int r = 0; r < 16; ++r) rli[r] = 0.0625f * __builtin_amdgcn_rcpf(li_l[crow(r, hi)]);
  }
  LBAR();
  lds_u8* stg = lds + wid * (32 * 272);
#pragma unroll
  for (int hv = 0; hv < VW; ++hv) {
#pragma unroll
    for (int r = 0; r < 16; r += 2) { const int orow = crow(odd ? r + 1 : r, hi);
#pragma unroll
      for (int dq = 0; dq < 4; ++dq) { const int d0 = hv * 4 + dq; const float a = o[d0][r] * rli[r], b = o[d0][r + 1] * rli[r + 1];
        const float recv = shx(odd ? a : b, 1, lane);
        float lo = odd ? recv : a, hi2 = odd ? b : recv;
        if constexpr (GATED) { const unsigned z = zr[r >> 1][d0]; const float z0 = __uint_as_float(z << 16), z1 = __uint_as_float(z & 0xffff0000u);
          lo *= z0 * __builtin_amdgcn_rcpf(1.f + __expf(-z0)); hi2 *= z1 * __builtin_amdgcn_rcpf(1.f + __expf(-z1)); }
        *(__attribute__((address_space(3))) unsigned*)(stg + orow * 272 + (dq * 32 + cpair) * 2) = cvtpk(lo, hi2); }
      if constexpr (VW == 2) SBAR(); }
    asm volatile("s_waitcnt lgkmcnt(0)" ::: "memory");
#pragma unroll
    for (int c8 = 0; c8 < 8; ++c8) { const int ch = c8 * 64 + lane, row = ch >> 4, c16 = ch & 15;
      const u32x4 w = *(const __attribute__((address_space(3))) u32x4*)(stg + row * 272 + c16 * 16);
      *(u32x4*)(Ow + (long)row * LDO + hv * 128 + c16 * 8) = w; }
    if constexpr (VW == 2) asm volatile("s_waitcnt lgkmcnt(0)" ::: "memory");
  }
#undef ISSUE
#undef WAITBAR
#undef LBAR
#undef RESC
#undef KFRAG
#undef VFRAG
#undef MM8
#undef MMQ
#undef DSR
#undef LW_
#undef F8
#undef QK2
#undef VRD
#undef PV2
#undef PIN
#undef TILE
}
}

constexpr int DM = 4096, NB = 2, SEQ = 4096, CTXL = 256, RB = SEQ + CTXL  , RT = NB * RB  ;
constexpr int INC = 13312, KVC = 3072, MIXW = 4096, OW = 6144;
constexpr int C_KA = 0, C_VA = 512, C_KC = 1024, C_VC = 2048, C_QA = 3072, C_QC = 5120, C_XB = 6144, C_BB = 7168, C_CB = 8192, C_ZA = 9216, C_ZB = 11264, C_ZC = 12288;
constexpr float EPS = 1e-6f;
constexpr int NPHASE = 14;

constexpr size_t MiB = 1u << 20;
constexpr size_t WS_CTL = 0, CTL_ZERO_BYTES = 1 * MiB;
constexpr size_t WS_ROPE = 1 * MiB;
constexpr size_t WS_WIN = 2 * MiB;
constexpr size_t WS_WOUT = 210 * MiB;
constexpr size_t WS_NB = 274 * MiB;
constexpr size_t WS_U = 342 * MiB;
constexpr size_t WS_O = 563 * MiB;
constexpr size_t WS_MIX = 767 * MiB;
constexpr size_t WS_H1 = 835 * MiB;
constexpr size_t WS_SLAB = 971 * MiB;
constexpr size_t WS_END = 1035 * MiB;
static_assert(WS_WIN + (size_t)2 * INC * DM * 2 <= WS_WOUT && WS_WOUT + (size_t)2 * DM * DM * 2 <= WS_NB && WS_NB + (size_t)RT * DM * 2 <= WS_U && WS_U + (size_t)RT * INC * 2 <= WS_O
              && WS_O + (size_t)RT * 2048 * 2 <= WS_MIX && WS_MIX + (size_t)RT * MIXW * 2 <= WS_H1 && WS_H1 + (size_t)RT * DM * 4 <= WS_SLAB && WS_SLAB + (size_t)8 * 512 * 4096 * 4 <= WS_END, "d_ws map");
constexpr int CW_TMO = 0, CW_CODE = 1;
constexpr int CW_BAR = 4096;
constexpr int CW_MOD = 16384;
static_assert((CW_MOD + 2 * 3 * 12288) * 4 <= (int)CTL_ZERO_BYTES, "CTL words inside the memset region");

constexpr int NWAVES = 8;
constexpr int RING_OFF = 0, RING_BYTES = 139264;
constexpr int LDSCTL_OFF = RING_BYTES, MISC_OFF = LDSCTL_OFF + 320;
constexpr int LDS_BYTES = 147456;
static_assert(MISC_OFF + 128 <= LDS_BYTES && pg8::STAGE_BYTES <= RING_BYTES && (int)att::SHM_ATTN <= RING_BYTES && att::dma_lds_bytes<2>() <= RING_BYTES && att::f8_lds_bytes<2>() <= RING_BYTES && WS_O + 198 * MiB <= WS_MIX, "LDS / fp8 workspace map");

#define GAS __attribute__((address_space(1)))
#define LAS __attribute__((address_space(3)))
typedef unsigned short bf16;
typedef unsigned v4u __attribute__((ext_vector_type(4)));
typedef unsigned v2u __attribute__((ext_vector_type(2)));
typedef float f32x4 __attribute__((ext_vector_type(4)));
typedef GAS unsigned gu32;
#define RLX_AGENT __ATOMIC_RELAXED, __HIP_MEMORY_SCOPE_AGENT
#define LDS_WAIT() asm volatile("s_waitcnt lgkmcnt(0)" ::: "memory")
#define VM_WAIT() asm volatile("s_waitcnt vmcnt(0)" ::: "memory")
__device__ __forceinline__ unsigned pk2(float lo, float hi) { return pg8::cvt_pk_bf16(lo, hi); }
__device__ __forceinline__ float bflo(unsigned w) { return __uint_as_float(w << 16); }
__device__ __forceinline__ float bfhi(unsigned w) { return __uint_as_float(w & 0xffff0000u); }
__device__ __forceinline__ float silu_f(float v) { return v / (1.f + __expf(-v)); }

#define XB_TMO      128
#define XB_XCNT(j)  (256  + 64 * (j))
#define XB_XSUB(j)  (1280 + 64 * (j))
#define XB_XGEN(j)  (2304 + 64 * (j))
#define XB_TOP      3328
#define XB_TOPGEN   3392
#define XCD_BAR_WORDS 3456
#define XB_SPIN_CAP (1u << 18)
__device__ __forceinline__ unsigned xb_ld(unsigned* p)              { return __hip_atomic_load(p, __ATOMIC_RELAXED, __HIP_MEMORY_SCOPE_AGENT); }
__device__ __forceinline__ unsigned xb_add(unsigned* p, unsigned v) { return __hip_atomic_fetch_add(p, v, __ATOMIC_RELAXED, __HIP_MEMORY_SCOPE_AGENT); }
__device__ __forceinline__ unsigned xb_xcc_id() { return (unsigned)__builtin_amdgcn_s_getreg((3 << 11) | 20) & 0xFu; }
#define XB_SPIN(cond, bar) do { unsigned _sp = 0; while (cond) { __builtin_amdgcn_s_sleep(1); \
    if ((++_sp & 255u) == 0u) { if (xb_ld(&(bar)[XB_TMO])) break; if (_sp > XB_SPIN_CAP) { atomicAdd(&(bar)[XB_TMO], 1u); break; } } } } while (0)
struct XcdBarrier { unsigned* bar; unsigned x; volatile LAS unsigned* st; int wv; };
__device__ __forceinline__ XcdBarrier xcd_barrier_post(unsigned* bar, volatile LAS unsigned* st, int wv) {
    XcdBarrier b; b.bar = bar; b.x = xb_xcc_id(); b.st = st; b.wv = wv;
    if (wv == 0 && hw_lane() == 0) (void)xb_add(&bar[XB_XCNT(b.x)], 1u);
    return b;
}
__device__ __forceinline__ void xcd_barrier_complete(unsigned* bar, unsigned x, unsigned& nloc, unsigned& nx) {
    const unsigned G = gridDim.x * gridDim.y * gridDim.z;
    unsigned sum, cnt, mine, sp = 0u;
    for (;;) {
        sum = 0u; cnt = 0u; mine = 0u;
#pragma unroll
        for (unsigned j = 0; j < 16; ++j) { const unsigned c = xb_ld(&bar[XB_XCNT(j)]); sum += c; cnt += (c > 0u) ? 1u : 0u; mine = (j == x) ? c : mine; }
        if (sum == G) break;
        __builtin_amdgcn_s_sleep(1);
        if ((++sp & 255u) == 0u) { if (xb_ld(&bar[XB_TMO])) break; if (sp > XB_SPIN_CAP) { atomicAdd(&bar[XB_TMO], 1u); break; } }
    }
    nloc = mine > 0u ? mine : 1u; nx = cnt > 0u ? cnt : 1u;
}
__device__ __forceinline__ void xcd_barrier(const XcdBarrier& b) {
    asm volatile("s_waitcnt vmcnt(0)" ::: "memory");
    __syncthreads();
    if (b.wv == 0 && hw_lane() == 0) {
        unsigned* bar = b.bar;
        __builtin_amdgcn_s_waitcnt(0);
        unsigned nloc = b.st[0], nx = b.st[1];
        if (nloc == 0u) { xcd_barrier_complete(bar, b.x, nloc, nx); b.st[0] = nloc; b.st[1] = nx; }
        const unsigned old = xb_add(&bar[XB_XSUB(b.x)], 1u);
        const unsigned gen = old / nloc;
        if (old + 1u == (gen + 1u) * nloc) {
            __builtin_amdgcn_fence(__ATOMIC_RELEASE, "agent");
            asm volatile("s_waitcnt vmcnt(0)" ::: "memory");
            const unsigned og = xb_add(&bar[XB_TOP], 1u);
            const unsigned tg = og / nx;
            if (og + 1u == (tg + 1u) * nx) xb_add(&bar[XB_TOPGEN], 1u);
            else XB_SPIN(xb_ld(&bar[XB_TOPGEN]) == tg, bar);
            __builtin_amdgcn_fence(__ATOMIC_ACQUIRE, "agent");
            xb_add(&bar[XB_XGEN(b.x)], 1u);
            asm volatile("s_waitcnt vmcnt(0)" ::: "memory");
        } else {
            XB_SPIN(xb_ld(&bar[XB_XGEN(b.x)]) == gen, bar);
            __builtin_amdgcn_fence(__ATOMIC_ACQUIRE, "agent");
            asm volatile("s_waitcnt vmcnt(0)" ::: "memory");
        }
    }
    __syncthreads();
}

__device__ __forceinline__ int launder(int v) { asm volatile("" : "+v"(v)); return v; }
__device__ __forceinline__ float wave_sum(float v, int lane) {
#pragma unroll
    for (int o = 1; o < 64; o <<= 1) v += att::shx(v, o, lane);
    return v;
}

struct Args { const float* in[18]; float* out; unsigned char* ws; int ph_lo, ph_hi; };

struct TItem { const float* src; bf16* dst; int N; unsigned char* dst8; };
__device__ __forceinline__ TItem t_locate(int it, const float* w_in, const float* w_out, bf16* WIN_T, bf16* WOUT_T, unsigned char* W8) {
    constexpr int I_IN = (DM / 64) * (INC / 64), I_OUT = (DM / 64) * (DM / 64);
    TItem t; int r = it;
    if (r < 2 * I_IN) { const int l = r / I_IN; r -= l * I_IN; const int kb = r / (INC / 64), nb = r - kb * (INC / 64);
        t.src = w_in + (size_t)l * DM * INC + (size_t)(64 * kb) * INC + 64 * nb; t.dst = WIN_T + (size_t)l * INC * DM + (size_t)(64 * nb) * DM + 64 * kb; t.N = INC;
        const int tile = nb >> 2; t.dst8 = pg8::f8_tile(tile) ? W8 + ((size_t)l * (pg8::F8N * 256) + (size_t)pg8::f8_tile_index(tile) * 256 + (nb & 3) * 64) * 4096 + 64 * kb : nullptr; }
    else { r -= 2 * I_IN; const int l = r / I_OUT; r -= l * I_OUT; const int kb = r / (DM / 64), nb = r - kb * (DM / 64);
        t.src = w_out + (size_t)l * DM * DM + (size_t)(64 * kb) * DM + 64 * nb; t.dst = WOUT_T + (size_t)l * DM * DM + (size_t)(64 * nb) * DM + 64 * kb; t.N = DM; t.dst8 = nullptr; }
    return t;
}
__device__ __forceinline__ void t_load(f32x4 (&w)[16], const TItem& t, int lane) {
#pragma unroll
    for (int i = 0; i < 16; ++i) w[i] = __builtin_nontemporal_load((const f32x4*)(t.src + (size_t)(4 * i + (lane >> 4)) * t.N + 4 * (lane & 15)));
}
__device__ __forceinline__ void t_store(const f32x4 (&w)[16], bf16* dst, LAS float* scr, int lane, unsigned char* dst8 = nullptr) {
#pragma unroll
    for (int i = 0; i < 16; ++i) { const int kk = 4 * i + (lane >> 4); LAS float* d = scr + kk * 65 + 4 * (lane & 15); d[0] = w[i].x; d[1] = w[i].y; d[2] = w[i].z; d[3] = w[i].w; }
    LDS_WAIT(); asm volatile("" ::: "memory");
    const int c = lane & 7;
#pragma unroll
    for (int j = 0; j < 8; ++j) { const int n = (lane >> 3) + 8 * j; const LAS float* s = scr + (8 * c) * 65 + n;
        if (dst8) { unsigned f0 = 0u, f1 = 0u; f0 = __builtin_amdgcn_cvt_pk_fp8_f32(s[0 * 65] * 1024.f, s[1 * 65] * 1024.f, f0, false); f0 = __builtin_amdgcn_cvt_pk_fp8_f32(s[2 * 65] * 1024.f, s[3 * 65] * 1024.f, f0, true);
            f1 = __builtin_amdgcn_cvt_pk_fp8_f32(s[4 * 65] * 1024.f, s[5 * 65] * 1024.f, f1, false); f1 = __builtin_amdgcn_cvt_pk_fp8_f32(s[6 * 65] * 1024.f, s[7 * 65] * 1024.f, f1, true);
            v2u o8; o8.x = f0; o8.y = f1; *(v2u*)(dst8 + (size_t)n * 4096 + 8 * c) = o8; }
        else { v4u o; o.x = pk2(s[0 * 65], s[1 * 65]); o.y = pk2(s[2 * 65], s[3 * 65]); o.z = pk2(s[4 * 65], s[5 * 65]); o.w = pk2(s[6 * 65], s[7 * 65]);
        *(v4u*)(dst + (size_t)n * DM + 8 * c) = o; } }
    LDS_WAIT(); asm volatile("" ::: "memory");
}

__global__ void __launch_bounds__(NWAVES * 64, 2) mk_fwd(Args args) {
    extern __shared__ __attribute__((aligned(16))) unsigned char lds[];
    LAS unsigned char* ldsl = (LAS unsigned char*)lds;
    volatile LAS unsigned* MISC = (volatile LAS unsigned*)(ldsl + MISC_OFF);
    const int wave = __builtin_amdgcn_readfirstlane((int)threadIdx.x >> 6);
    const int G = gridDim.x; const int bx = blockIdx.x;
    const int vcu = (G % 8 == 0) ? (bx % 8) * (G / 8) + bx / 8 : bx;
    const int gw = vcu * NWAVES + wave, NGW = G * NWAVES;
    unsigned char* ws = args.ws;
    gu32* ctl = (gu32*)(ws + WS_CTL);
    const float* x = args.in[0]; const float* cvec = args.in[1]; const float* ctxin = args.in[2]; const float* cctx = args.in[3];
    const float* w_mod = args.in[4]; const float* b_mod = args.in[5]; const float* norm_g = args.in[6]; const float* w_in = args.in[7];
    const float* q_norm_a = args.in[8]; const float* k_norm_a = args.in[9]; const float* conv_w = args.in[10];
    const float* lq1 = args.in[11]; const float* lk1 = args.in[12]; const float* lq2 = args.in[13]; const float* lk2 = args.in[14];
    const float* subln_g = args.in[15]; const float* w_out = args.in[16]; const float* final_g = args.in[17];
    float* outp = args.out;
    float* MOD = (float*)(ws + WS_CTL) + CW_MOD;
    float* ROPE = (float*)(ws + WS_ROPE);
    bf16* WIN_T = (bf16*)(ws + WS_WIN); bf16* WOUT_T = (bf16*)(ws + WS_WOUT);
    bf16* NBUF = (bf16*)(ws + WS_NB); bf16* U = (bf16*)(ws + WS_U); bf16* OCB = (bf16*)(ws + WS_O); unsigned char* K8 = ws + WS_O + 40 * MiB; unsigned char* V8 = ws + WS_O + 48 * MiB; unsigned char* K8C = ws + WS_O + 56 * MiB; unsigned char* V8C = ws + WS_O + 66 * MiB; unsigned char* NB8 = ws + WS_O + 80 * MiB; unsigned char* W8 = ws + WS_O + 116 * MiB;         bf16* MIX = (bf16*)(ws + WS_MIX); bf16* DL = (bf16*)(ws + WS_H1); float* SLAB = (float*)(ws + WS_SLAB);

    for (int u = wave * 64 + hw_lane(); u < (LDS_BYTES - LDSCTL_OFF) / 4; u += NWAVES * 64) ((LAS unsigned*)(ldsl + LDSCTL_OFF))[u] = 0u;
    __syncthreads();
    XcdBarrier bar; bar.bar = (unsigned*)(ctl + CW_BAR); bar.x = 0; bar.st = nullptr;
    if (!MK_PER_PHASE) bar = xcd_barrier_post((unsigned*)(ctl + CW_BAR), MISC + 8, wave);
    const int lo = args.ph_lo, hi = args.ph_hi;
#define IN(k) (lo <= (k) && (k) < hi)
#define SEAM(k) do { if (IN(k) && IN((k) + 1)) xcd_barrier(bar); } while (0)
#define REPS(k) (((MK_REP >> (k)) & 1) + 1)
#define REPBAR(k) do { if (REPS(k) > 1 && rep + 1 < REPS(k)) xcd_barrier(bar); } while (0)

    if (IN(0)) for (int rep = 0; rep < REPS(0); ++rep) {
        const int lane = hw_lane(); const int tid = wave * 64 + lane;
        float* MODw = MOD + rep * 2 * 3 * 12288;
        {
            LAS float* sl = (LAS float*)(ldsl);
            for (int e = tid; e < 3 * 4096; e += NWAVES * 64) { const int r = e >> 12, k = e & 4095; const float v = (r < 2) ? cvec[r * 4096 + k] : cctx[k]; sl[e] = silu_f(v); }
            __syncthreads();
            LAS float* red = (LAS float*)(ldsl + 49152);
            for (int it = bx; it < 768; it += G) {
                const int layer = it / 384, rem = it - layer * 384, slab = rem >> 3, kc = rem & 7;
                const int col0 = slab * 256 + lane * 4, k0 = kc * 512 + wave * 64;
                const float* W = w_mod + (size_t)layer * 4096 * 12288 + (size_t)k0 * 12288 + col0;
                f32x4 a0 = {0.f, 0.f, 0.f, 0.f}, a1 = a0, a2 = a0;
                f32x4 wA[8], wB[8];
#pragma unroll
                for (int i = 0; i < 8; ++i) wA[i] = __builtin_nontemporal_load((const f32x4*)(W + (size_t)i * 12288));
                for (int kk = 0; kk < 64; kk += 16) {
#pragma unroll
                    for (int i = 0; i < 8; ++i) wB[i] = __builtin_nontemporal_load((const f32x4*)(W + (size_t)(kk + 8 + i) * 12288));
#pragma unroll
                    for (int i = 0; i < 8; ++i) { const float s0 = sl[k0 + kk + i], s1 = sl[4096 + k0 + kk + i], s2 = sl[8192 + k0 + kk + i];
                        a0 += wA[i] * s0; a1 += wA[i] * s1; a2 += wA[i] * s2; }
                    if (kk + 16 < 64) {
#pragma unroll
                        for (int i = 0; i < 8; ++i) wA[i] = __builtin_nontemporal_load((const f32x4*)(W + (size_t)(kk + 16 + i) * 12288));
                    }
#pragma unroll
                    for (int i = 0; i < 8; ++i) { const float s0 = sl[k0 + kk + 8 + i], s1 = sl[4096 + k0 + kk + 8 + i], s2 = sl[8192 + k0 + kk + 8 + i];
                        a0 += wB[i] * s0; a1 += wB[i] * s1; a2 += wB[i] * s2; }
                }
                *(LAS f32x4*)(red + (wave * 3 + 0) * 256 + lane * 4) = a0;
                *(LAS f32x4*)(red + (wave * 3 + 1) * 256 + lane * 4) = a1;
                *(LAS f32x4*)(red + (wave * 3 + 2) * 256 + lane * 4) = a2;
                __syncthreads();
                for (int e = tid; e < 768; e += NWAVES * 64) { const int r = e >> 8, c = e & 255; float s = 0.f;
#pragma unroll
                    for (int w8 = 0; w8 < 8; ++w8) s += red[(w8 * 3 + r) * 256 + c];
                    if (kc == 0) s += b_mod[layer * 12288 + slab * 256 + c];
                    atomicAdd(MODw + (layer * 3 + r) * 12288 + slab * 256 + c, s); }
                __syncthreads();
            }
        }
        for (int e = gw * 64 + lane; e < 2048; e += NGW * 64) { const int pos = e >> 5, j = e & 31; const float inv = powf(10000.f, -(float)j / 32.f); const float a = (float)pos * inv;
            ROPE[e] = cosf(a); ROPE[2048 + e] = sinf(a); }
        {
            LAS float* scr = (LAS float*)(ldsl + wave * (64 * 65 * 4));
            constexpr int NIT = 2 * ((DM / 64) * (INC / 64));
            f32x4 wa[16], wb[16]; TItem ta, tb; int it = gw;
            if (it < NIT) { ta = t_locate(it, w_in, w_out, WIN_T, WOUT_T, W8); t_load(wa, ta, lane); }
            while (it < NIT) {
                if (it + NGW < NIT) { tb = t_locate(it + NGW, w_in, w_out, WIN_T, WOUT_T, W8); t_load(wb, tb, lane); }
                t_store(wa, ta.dst, scr, lane, ta.dst8);
                it += NGW; if (it >= NIT) break;
                if (it + NGW < NIT) { ta = t_locate(it + NGW, w_in, w_out, WIN_T, WOUT_T, W8); t_load(wa, ta, lane); }
                t_store(wb, tb.dst, scr, lane, tb.dst8);
                it += NGW;
            }
        }
        __syncthreads();
        REPBAR(0);
    }
    SEAM(0);

    for (int layer = 0; layer < 2; ++layer) {
        const int pb = 1 + 6 * layer;
        const float* modL = MOD + layer * 3 * 12288;
        if (IN(pb + 0)) for (int rep = 0; rep < REPS(1); ++rep) {
            const int lane = hw_lane();
            const float* g = norm_g + layer * 4096;
            {
                LAS f32x4* av = (LAS f32x4*)ldsl;
                for (int e = wave * 64 + lane; e < 3 * 1024; e += NWAVES * 64) { const int c = e >> 10, k4 = e & 1023; const float* mr = modL + c * 12288;
                    const f32x4 gg = ((const f32x4*)g)[k4], sh = ((const f32x4*)mr)[k4], sc = ((const f32x4*)(mr + 4096))[k4];
                    av[(c * 2) * 1024 + k4] = gg * (sc + 1.f); av[(c * 2 + 1) * 1024 + k4] = sh; }
                __syncthreads();
            }
            for (int r = gw; r < RT; r += NGW) {
                const int b = r / RB, p = r - b * RB; const bool isctx = p < CTXL;
                const float* src = isctx ? ctxin + ((size_t)b * CTXL + p) * DM : x + ((size_t)b * SEQ + (p - CTXL)) * DM;
                const LAS f32x4* a4 = (const LAS f32x4*)ldsl + ((isctx ? 2 : b) * 2) * 1024;
                const f32x4* s4 = (const f32x4*)src + lane;
                f32x4 v[16]; float ss = 0.f;
                if (layer == 1 && isctx) {
                    const f32x4* g4 = (const f32x4*)(MOD + 2 * 12288 + 8192) + lane; const f32x4* sl4 = (const f32x4*)(SLAB + ((size_t)b * 256 + p) * 4096) + lane;
#pragma unroll
                    for (int j = 0; j < 16; ++j) { f32x4 a = sl4[64 * j];
#pragma unroll
                        for (int ks = 1; ks < 8; ++ks) a += sl4[(size_t)ks * 512 * 1024 + 64 * j];
                        v[j] = s4[64 * j] + g4[64 * j] * a; }
                } else if (layer == 1) {
                    const v2u* d2 = (const v2u*)(DL + (size_t)r * DM) + lane;
#pragma unroll
                    for (int j = 0; j < 16; ++j) { const v2u d = d2[64 * j]; v[j] = s4[64 * j] + (f32x4){bflo(d.x), bfhi(d.x), bflo(d.y), bfhi(d.y)}; }
                } else {
#pragma unroll
                    for (int j = 0; j < 16; ++j) v[j] = s4[64 * j];
                }
#pragma unroll
                for (int j = 0; j < 16; ++j) ss += (v[j].x * v[j].x + v[j].y * v[j].y) + (v[j].z * v[j].z + v[j].w * v[j].w);
                const float rstd = 1.f / sqrtf(wave_sum(ss, lane) * (1.f / DM) + EPS);
                v2u* o2 = (v2u*)(NBUF + (size_t)r * DM) + lane;
#pragma unroll
                for (int j = 0; j < 16; ++j) { const int ci = lane + 64 * j;
                    const f32x4 y = v[j] * rstd * a4[ci] + a4[1024 + ci];
                    v2u o; o.x = pk2(y.x, y.y); o.y = pk2(y.z, y.w); o2[64 * j] = o;
                    unsigned f = 0u; f = __builtin_amdgcn_cvt_pk_fp8_f32(y.x * 16.f, y.y * 16.f, f, false); f = __builtin_amdgcn_cvt_pk_fp8_f32(y.z * 16.f, y.w * 16.f, f, true);
                    ((unsigned*)(NB8 + (size_t)r * 4096))[ci] = f; }
            }
            __syncthreads();
            REPBAR(1);
        }
        SEAM(pb + 0);
        if (IN(pb + 1)) for (int rep = 0; rep < REPS(2); ++rep) {
            pg8::Gemm g{NBUF, WIN_T + (size_t)layer * INC * DM, DM, DM, DM, NB8, W8 + (size_t)layer * (pg8::F8N * 256) * 4096};
            int bxl = bx; asm volatile("" : "+s"(bxl));
            pg8::EpiBf16 E{U, INC};
            const int Mrows = (layer == 1) ? NB * SEQ : RT;
            const int bxr = G - 1 - bxl;
            pg8::RowMapOrder S; S.latent_only = (layer == 1); S.ctx_ntiles = (layer == 1) ? 4 : 0; S.colmap = 2; S.so.init(Mrows, pg8::BFN * 256, G, bxr);
            int first_idle; { const int nunits = S.so.nwg + 2 * S.ctx_ntiles, rounds = (nunits + G - 1) / G; first_idle = nunits - (rounds - 1) * G; asm volatile("" : "+s"(first_idle)); }
            int Gf = (layer == 1 && first_idle < G / 4) ? G - first_idle : G; asm volatile("" : "+s"(Gf));
            const int n8 = (Mrows / 256) * pg8::F8N + ((layer == 1) ? 16 : 0);
            const int light_lo = n8 % Gf, light_hi = Gf;
            if (bxl < Gf) { pg8::RowMapOrder S8; S8.latent_only = (layer == 1); S8.ctx_ntiles = (layer == 1) ? 8 : 0; S8.colmap = 1; S8.so.init(Mrows, pg8::F8N * 256, Gf, bxl);
              pg8::gemm_phase<pg8::EpiBf16, pg8::RowMapOrder, false, true, true>(ldsl + RING_OFF, g, S8, E, wave); }
            pg8::gemm_phase<pg8::EpiBf16, pg8::RowMapOrder, false, true, false>(ldsl + RING_OFF, g, S, E, wave);
            {
                const int lane = hw_lane();
                constexpr int I_IN2 = 2 * (DM / 64) * (INC / 64), I_OUT = (DM / 64) * (DM / 64);
                const bool helper = (Gf < G) ? (bxl >= light_lo && bxl < light_hi) : ((first_idle < G) && (bxr >= first_idle));
                const int nh = (Gf < G) ? (light_hi - light_lo) * NWAVES : helper ? (G - first_idle) * NWAVES : G * NWAVES;
                const int hr = (Gf < G) ? (bxl - light_lo) * NWAVES + wave : helper ? (bxr - first_idle) * NWAVES + wave : bxr * NWAVES + wave;
                if (helper || first_idle >= G) {
                    LAS float* scr = (LAS float*)(ldsl + wave * (64 * 65 * 4));
                    for (int it = hr; it < I_OUT; it += nh) { f32x4 wa[16]; const TItem ta = t_locate(I_IN2 + layer * I_OUT + it, w_in, w_out, WIN_T, WOUT_T, W8); t_load(wa, ta, lane); t_store(wa, ta.dst, scr, lane, ta.dst8); }
                }
            }
            REPBAR(2);
        }
        SEAM(pb + 1);
        if (IN(pb + 2)) for (int rep = 0; rep < REPS(3); ++rep) {
            const int lane = hw_lane();
            const size_t wr_off = rep ? (size_t)(WS_END - WS_U) / 2 : 0;
            const float* qn = q_norm_a + layer * 128; const float* kn = k_norm_a + layer * 128; const float* cw = conv_w + layer * 3 * 1024;
            const int nitems = RT * 11;
            for (int it = gw; it < nitems; it += NGW) {
                const int r = it / 11, sub = it - r * 11;
                const int b = r / RB, p = r - b * RB; const bool isctx = p < CTXL; const int t = isctx ? p : p - CTXL;
                if (layer == 1 && isctx && sub >= 3) continue;
                if (sub >= 3 && sub < 9) continue;
                bf16* urow = U + (size_t)r * INC;
                if (sub < 9) {
                    const int cbase = (sub == 0) ? C_KA : (sub < 3) ? C_KC + (sub - 1) * 512 : (sub < 7) ? C_QA + (sub - 3) * 512 : C_QC + (sub - 7) * 512;
                    const bool donorm = (sub == 0) || (sub >= 3 && sub < 7);
                    const float* gn = (sub == 0) ? kn : qn;
                    v4u* ptr = (v4u*)(urow + cbase + lane * 8);
                    const v4u raw = *ptr;
                    float xv[8] = {bflo(raw.x), bfhi(raw.x), bflo(raw.y), bfhi(raw.y), bflo(raw.z), bfhi(raw.z), bflo(raw.w), bfhi(raw.w)};
                    const int d0 = (lane & 15) * 8;
                    if (donorm) {
                        float ss = 0.f;
#pragma unroll
                        for (int i = 0; i < 8; ++i) ss += xv[i] * xv[i];
                        ss += att::shx(ss, 1, lane); ss += att::shx(ss, 2, lane); ss += att::shx(ss, 4, lane); ss += att::shx(ss, 8, lane);
                        const float rstd = 1.f / sqrtf(ss * (1.f / 128.f) + EPS);
                        const f32x4 g0 = *(const f32x4*)(gn + d0), g1 = *(const f32x4*)(gn + d0 + 4);
                        xv[0] *= rstd * g0.x; xv[1] *= rstd * g0.y; xv[2] *= rstd * g0.z; xv[3] *= rstd * g0.w;
                        xv[4] *= rstd * g1.x; xv[5] *= rstd * g1.y; xv[6] *= rstd * g1.z; xv[7] *= rstd * g1.w;
                    }
                    if (!isctx) {
                        const int pos = (d0 < 64) ? (t >> 6) : (t & 63); const int j0 = d0 & 31; const bool first = (d0 & 32) == 0;
                        const f32x4 c0 = *(const f32x4*)(ROPE + pos * 32 + j0), c1 = *(const f32x4*)(ROPE + pos * 32 + j0 + 4);
                        const f32x4 s0 = *(const f32x4*)(ROPE + 2048 + pos * 32 + j0), s1 = *(const f32x4*)(ROPE + 2048 + pos * 32 + j0 + 4);
                        const float cs[8] = {c0.x, c0.y, c0.z, c0.w, c1.x, c1.y, c1.z, c1.w}; const float sn[8] = {s0.x, s0.y, s0.z, s0.w, s1.x, s1.y, s1.z, s1.w};
#pragma unroll
                        for (int i = 0; i < 8; ++i) { const float pr = att::shx(xv[i], 4, lane); xv[i] = first ? (xv[i] * cs[i] - pr * sn[i]) : (xv[i] * cs[i] + pr * sn[i]); }
                    }
                    if (sub < 3) {
                        const int j = lane & 15, s0 = (j >> 3) * 64 + (j & 1) * 32 + ((j >> 1) & 3) * 8; unsigned w0 = 0u, w1 = 0u;
                        w0 = __builtin_amdgcn_cvt_pk_fp8_f32(xv[0] * 16.f, xv[1] * 16.f, w0, false); w0 = __builtin_amdgcn_cvt_pk_fp8_f32(xv[2] * 16.f, xv[3] * 16.f, w0, true);
                        w1 = __builtin_amdgcn_cvt_pk_fp8_f32(xv[4] * 16.f, xv[5] * 16.f, w1, false); w1 = __builtin_amdgcn_cvt_pk_fp8_f32(xv[6] * 16.f, xv[7] * 16.f, w1, true);
                        unsigned char* kdst = (sub == 0) ? K8 + ((size_t)(b * 4 + (lane >> 4)) * RB + p) * 128 : K8C + ((size_t)(b * 8 + (sub - 1) * 4 + (lane >> 4)) * RB + p) * 128;
                        v2u o8; o8.x = w0; o8.y = w1; *(v2u*)(kdst + s0) = o8;
                        continue; }
                    v4u o; o.x = pk2(xv[0], xv[1]); o.y = pk2(xv[2], xv[3]); o.z = pk2(xv[4], xv[5]); o.w = pk2(xv[6], xv[7]);
                    if (donorm || !isctx) *(ptr + wr_off / 8) = o;
                } else {
                    const int ch = (sub - 9) * 512 + lane * 8; const int T = isctx ? CTXL : SEQ;
                    const v4u xb = *(const v4u*)(urow + C_XB + ch), bb = *(const v4u*)(urow + C_BB + ch), cb = *(const v4u*)(urow + C_CB + ch), zb = *(const v4u*)(urow + C_ZB + ch);
                    v4u xp = {0u, 0u, 0u, 0u}, cp = xp, xn = xp, cn = xp;
                    if (t > 0) { xp = *(const v4u*)(urow - INC + C_XB + ch); cp = *(const v4u*)(urow - INC + C_CB + ch); }
                    if (t < T - 1) { xn = *(const v4u*)(urow + INC + C_XB + ch); cn = *(const v4u*)(urow + INC + C_CB + ch); }
                    const f32x4 w0a = *(const f32x4*)(cw + ch), w0b = *(const f32x4*)(cw + ch + 4), w1a = *(const f32x4*)(cw + 1024 + ch), w1b = *(const f32x4*)(cw + 1024 + ch + 4),
                                w2a = *(const f32x4*)(cw + 2048 + ch), w2b = *(const f32x4*)(cw + 2048 + ch + 4);
                    const float w0[8] = {w0a.x, w0a.y, w0a.z, w0a.w, w0b.x, w0b.y, w0b.z, w0b.w}, w1[8] = {w1a.x, w1a.y, w1a.z, w1a.w, w1b.x, w1b.y, w1b.z, w1b.w},
                                w2[8] = {w2a.x, w2a.y, w2a.z, w2a.w, w2b.x, w2b.y, w2b.z, w2b.w};
                    const unsigned xbw[4] = {xb.x, xb.y, xb.z, xb.w}, bbw[4] = {bb.x, bb.y, bb.z, bb.w}, cbw[4] = {cb.x, cb.y, cb.z, cb.w}, zbw[4] = {zb.x, zb.y, zb.z, zb.w},
                                   xpw[4] = {xp.x, xp.y, xp.z, xp.w}, cpw[4] = {cp.x, cp.y, cp.z, cp.w}, xnw[4] = {xn.x, xn.y, xn.z, xn.w}, cnw[4] = {cn.x, cn.y, cn.z, cn.w};
                    float y[8];
#pragma unroll
                    for (int i = 0; i < 4; ++i) {
                        { const float conv = bflo(cpw[i]) * bflo(xpw[i]) * w0[2 * i] + bflo(cbw[i]) * bflo(xbw[i]) * w1[2 * i] + bflo(cnw[i]) * bflo(xnw[i]) * w2[2 * i];
                          y[2 * i] = bflo(bbw[i]) * conv * silu_f(bflo(zbw[i])); }
                        { const float conv = bfhi(cpw[i]) * bfhi(xpw[i]) * w0[2 * i + 1] + bfhi(cbw[i]) * bfhi(xbw[i]) * w1[2 * i + 1] + bfhi(cnw[i]) * bfhi(xnw[i]) * w2[2 * i + 1];
                          y[2 * i + 1] = bfhi(bbw[i]) * conv * silu_f(bfhi(zbw[i])); }
                    }
                    v4u o; o.x = pk2(y[0], y[1]); o.y = pk2(y[2], y[3]); o.z = pk2(y[4], y[5]); o.w = pk2(y[6], y[7]);
                    *(v4u*)(MIX + (size_t)r * MIXW + 2048 + ch) = o;
                }
            }
            {
                LAS unsigned char* scr = ldsl + wave * 16384;
                const int k = lane, blk = k >> 5, kk = k & 31, pos = ((kk >> 2) & 1) * 32 + blk * 16 + (kk >> 3) * 4 + (kk & 3);
                const int ntile = (layer == 1) ? NB * 4 * 68 : NB * 4 * 68;
                for (int it = gw; it < ntile; it += NGW) {
                    const int bk = it / 68, j = it - bk * 68, b = bk >> 2, kvh = bk & 3;
                    const bf16* src = U + (size_t)(b * RB + j * 64 + k) * INC + C_VA + kvh * 128;
#pragma unroll
                    for (int c = 0; c < 16; ++c) { const v4u raw = *(const v4u*)(src + c * 8); const unsigned rw[4] = {raw.x, raw.y, raw.z, raw.w};
#pragma unroll
                        for (int e = 0; e < 4; ++e) { unsigned f = 0u; f = __builtin_amdgcn_cvt_pk_fp8_f32(bflo(rw[e]) * 16.f, bfhi(rw[e]) * 16.f, f, false);
                            scr[(c * 8 + 2 * e) * 64 + pos] = (unsigned char)(f & 0xffu); scr[(c * 8 + 2 * e + 1) * 64 + pos] = (unsigned char)((f >> 8) & 0xffu); } }
                    LDS_WAIT(); asm volatile("" ::: "memory");
                    unsigned char* dst = V8 + ((size_t)bk * 68 + j) * 8192;
#pragma unroll
                    for (int c = 0; c < 8; ++c) *(v4u*)(dst + c * 1024 + lane * 16) = *(const LAS v4u*)(scr + c * 1024 + lane * 16);
                    LDS_WAIT(); asm volatile("" ::: "memory");
                }
                LAS unsigned char* scr2 = ldsl + wave * 16384;
                for (int it = gw; it < ntile; it += NGW) {
                    const int bk = it / 68, j = it - bk * 68, b = bk >> 2, h = bk & 3;
                    const bf16* src = U + (size_t)(b * RB + j * 64 + k) * INC + C_VC + h * 256;
#pragma unroll 4
                    for (int c = 0; c < 32; ++c) { const v4u raw = *(const v4u*)(src + c * 8); const unsigned rw[4] = {raw.x, raw.y, raw.z, raw.w};
#pragma unroll
                        for (int e = 0; e < 4; ++e) { unsigned f = 0u; f = __builtin_amdgcn_cvt_pk_fp8_f32(bflo(rw[e]) * 16.f, bfhi(rw[e]) * 16.f, f, false);
                            scr2[(c * 8 + 2 * e) * 64 + pos] = (unsigned char)(f & 0xffu); scr2[(c * 8 + 2 * e + 1) * 64 + pos] = (unsigned char)((f >> 8) & 0xffu); } }
                    LDS_WAIT(); asm volatile("" ::: "memory");
                    unsigned char* dst = V8C + ((size_t)bk * 68 + j) * 16384;
#pragma unroll
                    for (int c = 0; c < 16; ++c) *(v4u*)(dst + c * 1024 + lane * 16) = *(const LAS v4u*)(scr2 + c * 1024 + lane * 16);
                    LDS_WAIT(); asm volatile("" ::: "memory");
                }
            }
            REPBAR(3);
        }
        SEAM(pb + 2);
        if (IN(pb + 3)) for (int rep = 0; rep < REPS(4); ++rep) {
            const int nun = 768 + (layer == 0 ? 48 : 0);
            int vcl = vcu; asm volatile("" : "+s"(vcl));
            const att::bf16* Ub = (const att::bf16*)U;
            for (int L = vcl; L < nun; L += G) {
                int b, hd, qrow0, seq; bool diff;
                if (L < 512) { b = L >> 8; hd = (L >> 4) & 15; qrow0 = b * RB + CTXL + (L & 15) * 256; seq = RB; diff = false; }
                else if (L < 768) { const int w = L - 512; b = w >> 7; hd = (w >> 4) & 7; qrow0 = b * RB + CTXL + (w & 15) * 256; seq = RB; diff = true; }
                else { const int c = L - 768; seq = CTXL; if (c < 32) { b = c >> 4; hd = c & 15; diff = false; } else { b = (c - 32) >> 3; hd = (c - 32) & 7; diff = true; } qrow0 = b * RB; }
                const float* qn = q_norm_a + layer * 128; const float* qrp = (seq == RB) ? ROPE : nullptr; const int qt0 = qrow0 - b * RB - CTXL;
                if (!diff) {
                    const att::bf16* q = Ub + (size_t)qrow0 * INC + C_QA + hd * 128;
                    bf16* o = (rep ? (bf16*)(ws + WS_END) : MIX) + (size_t)qrow0 * MIXW + hd * 128; const bf16* z = U + (size_t)qrow0 * INC + C_ZA + hd * 128;
                    att::attn_fp8_body<1, INC, MIXW, INC, true>(q, K8 + (size_t)(b * 4 + (hd >> 2)) * RB * 128, V8 + (size_t)(b * 4 + (hd >> 2)) * 68 * 8192, o, z, seq, (att::lds_u8*)ldsl, qn, qrp, qt0, wave);
                } else {
                    const att::bf16* q = Ub + (size_t)qrow0 * INC + C_QC + hd * 128;
                    bf16* o = (rep ? (bf16*)(ws + WS_END) + (size_t)RT * MIXW : OCB) + (size_t)qrow0 * 2048 + hd * 256;
                    att::attn_fp8_body<2, INC, 2048, INC, false>(q, K8C + (size_t)(b * 8 + hd) * RB * 128, V8C + (size_t)(b * 4 + (hd >> 1)) * 68 * 16384, o, o, seq, (att::lds_u8*)ldsl, nullptr, qrp, qt0, wave);
                }
                __syncthreads();
            }
            REPBAR(4);
        }
        SEAM(pb + 3);
        if (IN(pb + 4)) for (int rep = 0; rep < REPS(5); ++rep) {
            const int lane = hw_lane();
            int lyr = layer; asm volatile("" : "+s"(lyr));
            unsigned u08 = 0x3f4ccccdu; asm volatile("" : "+s"(u08));
            const float l_init = __uint_as_float(u08) - 0.6f * expf(-0.3f * (float)lyr);
            float lam;
            { const float* a1 = lq1 + lyr * 128; const float* b1 = lk1 + lyr * 128; const float* a2 = lq2 + lyr * 128; const float* b2 = lk2 + lyr * 128;
              const float s1 = wave_sum(a1[lane] * b1[lane] + a1[lane + 64] * b1[lane + 64], lane); const float s2 = wave_sum(a2[lane] * b2[lane] + a2[lane + 64] * b2[lane + 64], lane);
              lam = expf(s1) - expf(s2) + l_init; }
            const float* sg = subln_g + lyr * 256;
            const f32x4 sg4 = *(const f32x4*)(sg + lane * 4);
            for (int r = gw; r < RT; r += NGW) {
                const int b = r / RB, p = r - b * RB; if (layer == 1 && p < CTXL) continue;
                const bf16* orow = OCB + (size_t)r * 2048; const bf16* urow = U + (size_t)r * INC; bf16* mrow = MIX + (size_t)r * MIXW;
#pragma unroll
                for (int h = 0; h < 4; ++h) { const int e = lane * 4;
                    const v2u a0 = *(const v2u*)(orow + (h * 2 + 0) * 256 + e), a1 = *(const v2u*)(orow + (h * 2 + 1) * 256 + e);
                    const f32x4 o0 = {bflo(a0.x), bfhi(a0.x), bflo(a0.y), bfhi(a0.y)}, o1 = {bflo(a1.x), bfhi(a1.x), bflo(a1.y), bfhi(a1.y)};
                    const f32x4 d = o0 - o1 * lam;
                    const float ss = wave_sum((d.x * d.x + d.y * d.y) + (d.z * d.z + d.w * d.w), lane);
                    const float rstd = 1.f / sqrtf(ss * (1.f / 256.f) + EPS) * (1.f - l_init);
                    const v2u z = *(const v2u*)(urow + C_ZC + h * 256 + e);
                    v2u o; o.x = pk2(d.x * rstd * sg4.x * silu_f(bflo(z.x)), d.y * rstd * sg4.y * silu_f(bfhi(z.x)));
                    o.y = pk2(d.z * rstd * sg4.z * silu_f(bflo(z.y)), d.w * rstd * sg4.w * silu_f(bfhi(z.y)));
                    *(v2u*)(mrow + 3072 + h * 256 + e) = o; }
            }
            REPBAR(5);
        }
        SEAM(pb + 4);
        if (IN(pb + 5)) for (int rep = 0; rep < REPS(6); ++rep) {
            pg8::Gemm g{MIX, WOUT_T + (size_t)layer * DM * DM, DM, DM, DM};
            int bxl = bx; asm volatile("" : "+s"(bxl));
            pg8::RowMapOrder S; S.latent_only = 1; S.ctx_ntiles = 0; S.so.init(NB * SEQ, DM, G, bxl);
            pg8::EpiGate E{DL + (size_t)layer * RT * DM, modL};
            pg8::gemm_phase<pg8::EpiGate, pg8::RowMapOrder, false, true>(ldsl + RING_OFF, g, S, E, wave);
            if (layer == 0) {
                pg8::Gemm g2{MIX, WOUT_T, DM, DM, 512};
                pg8::CtxSplitOrder S2{G, bxl};
                pg8::EpiSlab E2{SLAB};
                pg8::gemm_phase<pg8::EpiSlab, pg8::CtxSplitOrder, true, true>(ldsl + RING_OFF, g2, S2, E2, wave);
            }
            REPBAR(6);
        }
        SEAM(pb + 5);
    }
    if (IN(13)) for (int rep = 0; rep < REPS(7); ++rep) {
        const int lane = hw_lane();
        { LAS f32x4* gv = (LAS f32x4*)ldsl; for (int e = wave * 64 + lane; e < 1024; e += NWAVES * 64) gv[e] = ((const f32x4*)final_g)[e]; __syncthreads(); }
        for (int ro = gw; ro < NB * SEQ; ro += NGW) {
            const int b = ro >> 12, r = ro + (b + 1) * CTXL;
            const f32x4* s4 = (const f32x4*)(x + (size_t)ro * DM) + lane; const v2u* d0 = (const v2u*)(DL + (size_t)r * DM) + lane; const v2u* d1 = (const v2u*)(DL + (size_t)(RT + r) * DM) + lane;
            f32x4* d4 = (f32x4*)((rep ? (float*)(ws + WS_END) : outp) + (size_t)ro * DM) + lane;
            f32x4 v[16]; float ss = 0.f;
#pragma unroll
            for (int j = 0; j < 16; ++j) { const v2u a = d0[64 * j], c = d1[64 * j];
                v[j] = s4[64 * j] + (f32x4){bflo(a.x), bfhi(a.x), bflo(a.y), bfhi(a.y)} + (f32x4){bflo(c.x), bfhi(c.x), bflo(c.y), bfhi(c.y)};
                ss += (v[j].x * v[j].x + v[j].y * v[j].y) + (v[j].z * v[j].z + v[j].w * v[j].w); }
            const float rstd = 1.f / sqrtf(wave_sum(ss, lane) * (1.f / DM) + EPS);
#pragma unroll
            for (int j = 0; j < 16; ++j) { const f32x4 gg = ((const LAS f32x4*)ldsl)[lane + 64 * j]; d4[64 * j] = v[j] * rstd * gg; }
        }
        REPBAR(7);
    }
#undef IN
#undef SEAM
}

extern "C" void kernel_launch(void* const* d_in, const int* in_sizes, int n_in, void* d_out, int out_size, void* d_ws, size_t ws_size, hipStream_t stream) {
    static int grid = 0;
    if (grid == 0) {
        if (n_in != 18 || in_sizes[0] != NB * SEQ * DM || out_size != NB * SEQ * DM || ws_size < WS_END) {
            fprintf(stderr, "kernel_launch: shape/workspace mismatch: n_in %d in0 %d out %d ws %zu (need %zu)\n", n_in, n_in > 0 ? in_sizes[0] : -1, out_size, ws_size, (size_t)WS_END); grid = -1; return; }
        int dev = 0, cus = 0, per_cu = 0;
        if (hipGetDevice(&dev) != hipSuccess || hipDeviceGetAttribute(&cus, hipDeviceAttributeMultiprocessorCount, dev) != hipSuccess) { fprintf(stderr, "kernel_launch: device query failed\n"); grid = -1; return; }
        if (hipFuncSetAttribute((const void*)mk_fwd, hipFuncAttributeMaxDynamicSharedMemorySize, LDS_BYTES) != hipSuccess) { fprintf(stderr, "kernel_launch: hipFuncSetAttribute failed\n"); grid = -1; return; }
        if (hipOccupancyMaxActiveBlocksPerMultiprocessor(&per_cu, (const void*)mk_fwd, NWAVES * 64, LDS_BYTES) != hipSuccess || per_cu < 1)
            fprintf(stderr, "kernel_launch: note: occupancy query reports %d workgroups per CU\n", per_cu);
        (void)hipGetLastError();
        grid = cus;
    }
    if (grid < 0) return;
    if (hipMemsetAsync((char*)d_ws + WS_CTL, 0, CTL_ZERO_BYTES, stream) != hipSuccess) { fprintf(stderr, "kernel_launch: memset failed\n"); return; }
    Args a{};
    for (int i = 0; i < 18; ++i) a.in[i] = (const float*)d_in[i];
    a.out = (float*)d_out; a.ws = (unsigned char*)d_ws;
#if MK_PER_PHASE
    for (int ph = 0; ph < NPHASE; ++ph) { a.ph_lo = ph; a.ph_hi = ph + 1; hipLaunchKernelGGL(mk_fwd, dim3(grid), dim3(NWAVES * 64), LDS_BYTES, stream, a); }
#else
    a.ph_lo = 0; a.ph_hi = NPHASE;
    hipLaunchKernelGGL(mk_fwd, dim3(grid), dim3(NWAVES * 64), LDS_BYTES, stream, a);
#endif
    const hipError_t le = hipPeekAtLastError();
    if (le != hipSuccess) fprintf(stderr, "kernel_launch: launch failed: %s\n", hipGetErrorName(le));
}
```
